# Optimizing an MI355X kernel written in HIP

```python
import math
import jax, jax.numpy as jnp
from jax import lax
import numpy as np

D_MODEL = 1024
BATCH = 8
SEQ = 8192
DEPTH = 4

GRID_W = 64
CTX_LEN = 256
N_MIXERS = 2
N_A = (DEPTH + 1) // 2
N_B = DEPTH // 2
D_MIX = D_MODEL
CHUNK = 128
CM_GROUPS = 8
CM_GROUP_DIM = D_MIX // CM_GROUPS
SSM_GROUP = 16
SSM_GROUPS = D_MIX // SSM_GROUP
SSM_STATE = 64
PEER_HEADS = 8
PEER_KEYS = 128
PEER_EXPERTS = PEER_KEYS * PEER_KEYS
PEER_TOPK = 16
PEER_DKEY = 512
PEER_DHALF = PEER_DKEY // 2
PEER_BLOCK = 128
N_MOD = 6
EPS = 1e-6

kernel_name = "hybrid_gmlp_s5_peer_dit"


def _rmsnorm(x, g):
    x32 = x.astype(jnp.float32)
    y = x32 * lax.rsqrt(jnp.mean(x32 * x32, axis=-1, keepdims=True) + EPS)
    return (y * g.astype(jnp.float32)).astype(x.dtype)


def _layernorm(x, g, b):
    x32 = x.astype(jnp.float32)
    mu = jnp.mean(x32, axis=-1, keepdims=True)
    xc = x32 - mu
    y = xc * lax.rsqrt(jnp.mean(xc * xc, axis=-1, keepdims=True) + EPS)
    return (y * g.astype(jnp.float32) + b.astype(jnp.float32)).astype(x.dtype)


def _modulate(h, shift, scale):
    return h * (1.0 + scale) + shift


def _sincos_1d(pos, dim):
    omega = 1.0 / (10000.0 ** (jnp.arange(dim // 2, dtype=jnp.float32) / (dim // 2)))
    ang = pos[:, None] * omega[None, :]
    return jnp.concatenate([jnp.sin(ang), jnp.cos(ang)], axis=-1)


def _pos_embed_2d(rows, dim):
    r = jnp.repeat(jnp.arange(rows, dtype=jnp.float32), GRID_W)
    col = jnp.tile(jnp.arange(GRID_W, dtype=jnp.float32), rows)
    return jnp.concatenate([_sincos_1d(r, dim // 2), _sincos_1d(col, dim // 2)], axis=-1)


def _chunk_mixer(h, w_in, ln_g, ln_b, w_s, b_s, w_out):
    bsz, length, _ = h.shape
    z = jax.nn.gelu(h @ w_in)
    u, v = jnp.split(z, 2, axis=-1)
    v = _layernorm(v, ln_g, ln_b)
    v = v.reshape(bsz, length // CHUNK, CHUNK, CM_GROUPS, CM_GROUP_DIM)
    v = jnp.einsum("hpq,bnqhd->bnphd", w_s, v) + b_s.T[:, :, None]
    return (u * v.reshape(bsz, length, D_MIX)) @ w_out


def _cmul(ar, ai, br, bi):
    return ar * br - ai * bi, ar * bi + ai * br


def _scan_combine(e1, e2):
    a1r, a1i, b1r, b1i = e1
    a2r, a2i, b2r, b2i = e2
    ar, ai = _cmul(a2r, a2i, a1r, a1i)
    br, bi = _cmul(a2r, a2i, b1r, b1i)
    return ar, ai, br + b2r, bi + b2i


def _diag_scan(a_r, a_i, bu_r, bu_i, h0=None):
    if h0 is not None:
        inj_r, inj_i = _cmul(a_r, a_i, h0[0], h0[1])
        bu_r = bu_r.at[0].add(inj_r)
        bu_i = bu_i.at[0].add(inj_i)
    a_full_r = jnp.broadcast_to(a_r, bu_r.shape)
    a_full_i = jnp.broadcast_to(a_i, bu_i.shape)
    _, _, h_r, h_i = lax.associative_scan(_scan_combine, (a_full_r, a_full_i, bu_r, bu_i), axis=0)
    return h_r, h_i


def _ssm_direction(u_lat, u_ctx, a_r, a_i, bb_r, bb_i, c_r, c_i, need_ctx_out):
    def inject(u):
        return (jnp.einsum("lgc,gpc->lgp", u, bb_r), jnp.einsum("lgc,gpc->lgp", u, bb_i))

    def readout(h_r, h_i):
        return jnp.einsum("lgp,gcp->lgc", h_r, c_r) - jnp.einsum("lgp,gcp->lgc", h_i, c_i)

    hc_r, hc_i = _diag_scan(a_r, a_i, *inject(u_ctx))
    hx_r, hx_i = _diag_scan(a_r, a_i, *inject(u_lat), h0=(hc_r[-1], hc_i[-1]))
    if need_ctx_out:
        return readout(hx_r, hx_i), readout(hc_r, hc_i)
    return readout(hx_r, hx_i), None


def _ssm_mixer(xn, cn, w_in, lam_re, lam_im, log_step, b_re, b_im, c_re, c_im, d_skip, w_out,
               need_ctx_out):
    u_x = xn @ w_in
    u_c = cn @ w_in
    lr = lam_re.astype(jnp.float32)
    li = lam_im.astype(jnp.float32)
    step = jnp.exp(log_step.astype(jnp.float32))[..., None]
    mag = jnp.exp(lr * step)
    a_r = mag * jnp.cos(li * step)
    a_i = mag * jnp.sin(li * step)
    den = lr * lr + li * li
    coef_r = ((a_r - 1.0) * lr + a_i * li) / den
    coef_i = (a_i * lr - (a_r - 1.0) * li) / den
    bb_r, bb_i = _cmul(coef_r[..., None], coef_i[..., None],
                       b_re.astype(jnp.float32), b_im.astype(jnp.float32))
    c_r = c_re.astype(jnp.float32)
    c_i = c_im.astype(jnp.float32)

    def per_sample(args):
        ux, uc = args
        ux = ux.astype(jnp.float32).reshape(-1, SSM_GROUPS, SSM_GROUP)
        uc = uc.astype(jnp.float32).reshape(-1, SSM_GROUPS, SSM_GROUP)
        yf_x, yf_c = _ssm_direction(ux, uc, a_r[0], a_i[0], bb_r[0], bb_i[0], c_r[0], c_i[0],
                                    need_ctx_out)
        yb_x, yb_c = _ssm_direction(ux[::-1], uc[::-1], a_r[1], a_i[1], bb_r[1], bb_i[1],
                                    c_r[1], c_i[1], need_ctx_out)
        y_lat = yf_x + yb_x[::-1]
        if need_ctx_out:
            return y_lat, yf_c + yb_c[::-1]
        return y_lat

    out = lax.map(per_sample, (u_x, u_c))

    def finish(y, u):
        y = y.reshape(u.shape).astype(u.dtype) + d_skip * u
        val, gate = jnp.split(jax.nn.gelu(y) @ w_out, 2, axis=-1)
        return val * jax.nn.sigmoid(gate)

    if need_ctx_out:
        return finish(out[0], u_x), finish(out[1], u_c)
    return finish(out, u_x), None


def _peer(h, w_q, sub_keys, u_tab, v_tab):
    shape = h.shape
    blocks = h.reshape(-1, PEER_BLOCK, D_MODEL)

    def block(hb):
        q = (hb @ w_q).reshape(PEER_BLOCK, PEER_HEADS, 2, PEER_DHALF)
        s = jnp.einsum("nhkd,hkmd->nhkm", q.astype(jnp.float32), sub_keys.astype(jnp.float32))
        s_half, i_half = lax.top_k(s, PEER_TOPK)
        cand = s_half[:, :, 0, :, None] + s_half[:, :, 1, None, :]
        top_s, top_c = lax.top_k(cand.reshape(PEER_BLOCK, PEER_HEADS, PEER_TOPK * PEER_TOPK),
                                 PEER_TOPK)
        k1 = jnp.take_along_axis(i_half[:, :, 0], top_c // PEER_TOPK, axis=-1)
        k2 = jnp.take_along_axis(i_half[:, :, 1], top_c % PEER_TOPK, axis=-1)
        ids = k1 * PEER_KEYS + k2
        g = jax.nn.softmax(top_s, axis=-1)
        ue = jnp.take(u_tab, ids, axis=0)
        ve = jnp.take(v_tab, ids, axis=0)
        act = jax.nn.gelu(jnp.einsum("nd,nhkd->nhk", hb, ue).astype(jnp.float32))
        return jnp.einsum("nhk,nhkd->nd", (g * act).astype(hb.dtype), ve)

    return lax.map(block, blocks).reshape(shape)


def setup_inputs(seed: int = 0) -> dict:
    key = jax.random.key(seed)
    ks = jax.random.split(key, 32)
    f32 = jnp.float32
    nrm = lambda k, s, std: jax.random.normal(k, s, f32) * std
    G, P = SSM_GROUPS, SSM_STATE
    lam_im0 = jnp.broadcast_to(jnp.pi * jnp.arange(P, dtype=f32), (N_B, 2, G, P))
    return {
        "x": nrm(ks[0], (BATCH, SEQ, D_MODEL), 1.0),
        "c": nrm(ks[1], (BATCH, D_MODEL), 1.0),
        "ctx": nrm(ks[2], (BATCH, CTX_LEN, D_MODEL), 1.0),
        "c_ctx": nrm(ks[3], (D_MODEL,), 1.0),
        "ada_w": nrm(ks[4], (DEPTH, D_MODEL, N_MOD * D_MODEL), 0.5 * D_MODEL ** -0.5),
        "ada_b": nrm(ks[5], (DEPTH, N_MOD * D_MODEL), 0.02),
        "norm1_g": 1.0 + nrm(ks[6], (DEPTH, D_MODEL), 0.02),
        "norm2_g": 1.0 + nrm(ks[7], (DEPTH, D_MODEL), 0.02),
        "final_g": 1.0 + nrm(ks[8], (D_MODEL,), 0.02),
        "cm_w_in": nrm(ks[9], (N_A, D_MODEL, 2 * D_MIX), D_MODEL ** -0.5),
        "cm_ln_g": 1.0 + nrm(ks[10], (N_A, D_MIX), 0.02),
        "cm_ln_b": nrm(ks[11], (N_A, D_MIX), 0.02),
        "cm_w_s": nrm(ks[12], (N_A, CM_GROUPS, CHUNK, CHUNK), CHUNK ** -0.5),
        "cm_b_s": 1.0 + nrm(ks[13], (N_A, CM_GROUPS, CHUNK), 0.02),
        "cm_w_out": nrm(ks[14], (N_A, D_MIX, D_MODEL), D_MIX ** -0.5),
        "ssm_w_in": nrm(ks[15], (N_B, D_MODEL, D_MIX), D_MODEL ** -0.5),
        "ssm_lam_re": -0.5 + nrm(ks[16], (N_B, 2, G, P), 0.01),
        "ssm_lam_im": lam_im0 + nrm(ks[17], (N_B, 2, G, P), 0.01),
        "ssm_log_step": jax.random.uniform(ks[18], (N_B, 2, G), f32,
                                           minval=math.log(1e-3), maxval=math.log(1e-1)),
        "ssm_b_re": nrm(ks[19], (N_B, 2, G, P, SSM_GROUP), (2 * SSM_GROUP) ** -0.5),
        "ssm_b_im": nrm(ks[20], (N_B, 2, G, P, SSM_GROUP), (2 * SSM_GROUP) ** -0.5),
        "ssm_c_re": nrm(ks[21], (N_B, 2, G, SSM_GROUP, P), P ** -0.5),
        "ssm_c_im": nrm(ks[22], (N_B, 2, G, SSM_GROUP, P), P ** -0.5),
        "ssm_d": nrm(ks[23], (N_B, D_MIX), 1.0),
        "ssm_w_out": nrm(ks[24], (N_B, D_MIX, 2 * D_MODEL), D_MIX ** -0.5),
        "peer_w_q": nrm(ks[25], (DEPTH, D_MODEL, PEER_HEADS * PEER_DKEY), D_MODEL ** -0.5),
        "peer_keys": nrm(ks[26], (DEPTH, PEER_HEADS, 2, PEER_KEYS, PEER_DHALF), PEER_DHALF ** -0.5),
        "peer_u": nrm(ks[27], (DEPTH, PEER_EXPERTS, D_MODEL), D_MODEL ** -0.5),
        "peer_v": nrm(ks[28], (DEPTH, PEER_EXPERTS, D_MODEL), (PEER_HEADS * PEER_TOPK) ** -0.5),
    }


def reference(x, c, ctx, c_ctx, ada_w, ada_b, norm1_g, norm2_g, final_g,
              cm_w_in, cm_ln_g, cm_ln_b, cm_w_s, cm_b_s, cm_w_out,
              ssm_w_in, ssm_lam_re, ssm_lam_im, ssm_log_step, ssm_b_re, ssm_b_im,
              ssm_c_re, ssm_c_im, ssm_d, ssm_w_out,
              peer_w_q, peer_keys, peer_u, peer_v):
    rows = x.shape[1] // GRID_W
    x = x + _pos_embed_2d(rows, D_MODEL).astype(x.dtype)[None]
    h_ctx = ctx
    silu_c = jax.nn.silu(c)
    silu_cc = jax.nn.silu(c_ctx)
    for i in range(DEPTH):
        last = i == DEPTH - 1
        k = i // N_MIXERS
        use_chunk = (i % N_MIXERS) == 0
        need_ctx_mix = (not last) or (not use_chunk)
        mod_x = (silu_c @ ada_w[i] + ada_b[i])[:, None, :]
        mod_c = (silu_cc @ ada_w[i] + ada_b[i])[None, None, :]
        sh1, sc1, g1, sh2, sc2, g2 = jnp.split(mod_x, N_MOD, axis=-1)
        csh1, csc1, cg1, csh2, csc2, cg2 = jnp.split(mod_c, N_MOD, axis=-1)

        xn = _modulate(_rmsnorm(x, norm1_g[i]), sh1, sc1)
        cn = _modulate(_rmsnorm(h_ctx, norm1_g[i]), csh1, csc1) if need_ctx_mix else None
        if use_chunk:
            y_x = _chunk_mixer(xn, cm_w_in[k], cm_ln_g[k], cm_ln_b[k], cm_w_s[k], cm_b_s[k],
                               cm_w_out[k])
            y_c = None if last else _chunk_mixer(cn, cm_w_in[k], cm_ln_g[k], cm_ln_b[k],
                                                 cm_w_s[k], cm_b_s[k], cm_w_out[k])
        else:
            y_x, y_c = _ssm_mixer(xn, cn, ssm_w_in[k], ssm_lam_re[k], ssm_lam_im[k],
                                  ssm_log_step[k], ssm_b_re[k], ssm_b_im[k], ssm_c_re[k],
                                  ssm_c_im[k], ssm_d[k], ssm_w_out[k], not last)
        x = x + g1 * y_x
        x = x + g2 * _peer(_modulate(_rmsnorm(x, norm2_g[i]), sh2, sc2),
                           peer_w_q[i], peer_keys[i], peer_u[i], peer_v[i])
        if not last:
            h_ctx = h_ctx + cg1 * y_c
            h_ctx = h_ctx + cg2 * _peer(_modulate(_rmsnorm(h_ctx, norm2_g[i]), csh2, csc2),
                                        peer_w_q[i], peer_keys[i], peer_u[i], peer_v[i])
    return _rmsnorm(x, final_g)
```

```cpp
#include <hip/hip_runtime.h>
#include <hip/hip_cooperative_groups.h>
#include <stdint.h>
#include <cstdio>
namespace cg = cooperative_groups;

#ifndef MULTI_LAUNCH
#define MULTI_LAUNCH 0
#endif

typedef short bf16x8 __attribute__((ext_vector_type(8)));
typedef float f32x16 __attribute__((ext_vector_type(16)));
typedef float f32x4 __attribute__((ext_vector_type(4)));
typedef __bf16 bf2 __attribute__((ext_vector_type(2)));
typedef uint16_t bf16_t;

constexpr int TL = 65536, TC = 2048, TT = TL + TC, DM = 1024;
constexpr int NPHASE = 29;

constexpr size_t OFF_HC   = 0;
constexpr size_t OFF_MODP = OFF_HC   + (size_t)TC * DM * 4;
constexpr size_t OFF_MOD  = OFF_MODP + (size_t)4 * 8 * 9 * 6144 * 4;
constexpr size_t OFF_PE   = OFF_MOD  + (size_t)4 * 9 * 6144 * 4;
constexpr size_t OFF_PART = OFF_PE   + (size_t)192 * 512 * 4;
constexpr size_t OFF_XN   = OFF_PART + (size_t)TT * 32 * 4;
constexpr size_t OFF_BUF1 = OFF_XN   + (size_t)TT * DM * 2;
constexpr size_t OFF_BUF2 = OFF_BUF1 + (size_t)TT * 2048 * 2;
constexpr size_t OFF_TOPK = OFF_BUF2 + (size_t)TT * DM * 2;
constexpr size_t OFF_WINC = OFF_TOPK + (size_t)TT * 256 * 4;
constexpr size_t OFF_WOUTC= OFF_WINC + (size_t)2 * 2048 * 1024 * 2;
constexpr size_t OFF_WINS = OFF_WOUTC+ (size_t)2 * 1024 * 1024 * 2;
constexpr size_t OFF_WOUTS= OFF_WINS + (size_t)2 * 1024 * 1024 * 2;
constexpr size_t OFF_WEFF = OFF_WOUTS+ (size_t)2 * 2048 * 1024 * 2;
constexpr size_t OFF_WS   = OFF_WEFF + (size_t)4 * 2048 * 1024 * 2;
constexpr size_t OFF_PU   = OFF_WS   + (size_t)2 * 8 * 128 * 128 * 2;
constexpr size_t OFF_PV   = OFF_PU   + (size_t)4 * 16384 * 1024 * 2;
constexpr size_t OFF_HN8  = OFF_PV + (size_t)4 * 16384 * 1024;
constexpr size_t WS_TOTAL = OFF_HN8 + (size_t)TT * 1024;

struct Params {
  const float* in[29];
  float* out;
  unsigned char* ws;
};
enum { I_X = 0, I_C, I_CTX, I_CCTX, I_ADAW, I_ADAB, I_N1G, I_N2G, I_FG, I_CMWIN, I_CMLNG, I_CMLNB, I_CMWS, I_CMBS,
       I_CMWOUT, I_SWIN, I_LRE, I_LIM, I_LSTEP, I_BRE, I_BIM, I_CRE, I_CIM, I_SD, I_SWOUT, I_PWQ, I_PKEYS, I_PU, I_PV };

__device__ __forceinline__ int threadIdx_x_raw() { return (int)__builtin_amdgcn_workitem_id_x(); }
__device__ __forceinline__ uint32_t pack_bf16(float a, float b) {
  bf2 v; v[0] = (__bf16)a; v[1] = (__bf16)b; return __builtin_bit_cast(uint32_t, v);
}
__device__ __forceinline__ float bf_lo(uint32_t w) { return __uint_as_float(w << 16); }
__device__ __forceinline__ float bf_hi(uint32_t w) { return __uint_as_float(w & 0xffff0000u); }
__device__ __forceinline__ float fast_rcp(float x) { return __builtin_amdgcn_rcpf(x); }
__device__ __forceinline__ float gelu_tanh(float x) {
  float u = 0.7978845608028654f * (x + 0.044715f * x * x * x);
  float e = __expf(-2.0f * u);
  return x * fast_rcp(1.0f + e);
}
__device__ __forceinline__ float sigmoidf_(float x) { return fast_rcp(1.0f + __expf(-x)); }
__device__ __forceinline__ float siluf_(float x) { return x / (1.0f + expf(-x)); }
__device__ __forceinline__ uint32_t ord_key(float f) {
  uint32_t b = __float_as_uint(f);
  return b ^ ((b >> 31) ? 0xffffffffu : 0x80000000u);
}
__device__ __forceinline__ float ord_dec(uint32_t o) {
  uint32_t b = (o & 0x80000000u) ? (o ^ 0x80000000u) : ~o;
  return __uint_as_float(b);
}
__device__ __forceinline__ float wave_sum(float v) {
#pragma unroll
  for (int o = 32; o > 0; o >>= 1) v += __shfl_xor(v, o);
  return v;
}
__device__ __forceinline__ float* xrow_ptr(const Params& p, int row) {
  return row < TL ? p.out + (size_t)row * DM : (float*)(p.ws + OFF_HC) + (size_t)(row - TL) * DM;
}
__device__ __forceinline__ int row_batch(int row) { return row < TL ? (row >> 13) : 8; }

__device__ __forceinline__ int tid_() { int t = threadIdx_x_raw(); asm volatile("" : "+v"(t)); return t; }
typedef uint32_t u32x2e __attribute__((ext_vector_type(2)));
typedef uint32_t u32x4e __attribute__((ext_vector_type(4)));
__device__ __forceinline__ void st_nt_u2(void* p, uint2 v) { const u32x2e t = {v.x, v.y}; __builtin_nontemporal_store(t, (u32x2e*)p); }
__device__ __forceinline__ void st_nt_u4(void* p, uint4 v) { const u32x4e t = {v.x, v.y, v.z, v.w}; __builtin_nontemporal_store(t, (u32x4e*)p); }
struct __attribute__((aligned(16))) Smem {
  uint4 a[2][1024];
  uint4 b[2][1024];
};
__device__ __forceinline__ int lds_idx(int row, int ch) { return row * 8 + (ch ^ ((row >> 1) & 7)); }

__device__ __forceinline__ void compute_ktile(int tid__, const Smem& sm, int buf, f32x16 (&acc)[2][2]) {
  const int lane = tid__ & 63, w = tid__ >> 6, wr = w >> 1, wc = w & 1;
  const int swz = ((lane & 31) >> 1) & 7;
#pragma unroll
  for (int ks = 0; ks < 4; ++ks) {
    const int ch = (ks * 2 + (lane >> 5)) ^ swz;
    bf16x8 af[2], bfr[2];
#pragma unroll
    for (int mi = 0; mi < 2; ++mi) {
      uint4 v = sm.a[buf][(wr * 64 + mi * 32 + (lane & 31)) * 8 + ch];
      af[mi] = *(bf16x8*)&v;
    }
#pragma unroll
    for (int ni = 0; ni < 2; ++ni) {
      uint4 v = sm.b[buf][(wc * 64 + ni * 32 + (lane & 31)) * 8 + ch];
      bfr[ni] = *(bf16x8*)&v;
    }
#pragma unroll
    for (int mi = 0; mi < 2; ++mi)
#pragma unroll
      for (int ni = 0; ni < 2; ++ni)
        acc[mi][ni] = __builtin_amdgcn_mfma_f32_32x32x16_bf16(bfr[ni], af[mi], acc[mi][ni], 0, 0, 0);
  }
}

struct Stage8 { uint4 a0, a1, a2, a3, b0, b1, b2, b3; };
__device__ __forceinline__ Stage8 g_load(const bf16_t* ga, const bf16_t* gb, int lda, int ldb, int kt) {
  Stage8 s;
  s.a0 = *(const uint4*)(ga + kt * 64);
  s.a1 = *(const uint4*)(ga + (size_t)32 * lda + kt * 64);
  s.a2 = *(const uint4*)(ga + (size_t)64 * lda + kt * 64);
  s.a3 = *(const uint4*)(ga + (size_t)96 * lda + kt * 64);
  s.b0 = *(const uint4*)(gb + kt * 64);
  s.b1 = *(const uint4*)(gb + (size_t)32 * ldb + kt * 64);
  s.b2 = *(const uint4*)(gb + (size_t)64 * ldb + kt * 64);
  s.b3 = *(const uint4*)(gb + (size_t)96 * ldb + kt * 64);
  return s;
}
__device__ __forceinline__ void g_store(const Stage8& s, Smem& sm, int buf, int sidx) {
  sm.a[buf][sidx] = s.a0; sm.a[buf][sidx + 256] = s.a1; sm.a[buf][sidx + 512] = s.a2; sm.a[buf][sidx + 768] = s.a3;
  sm.b[buf][sidx] = s.b0; sm.b[buf][sidx + 256] = s.b1; sm.b[buf][sidx + 512] = s.b2; sm.b[buf][sidx + 768] = s.b3;
}
__device__ __forceinline__ void gemm_tile(int tid__, const bf16_t* __restrict__ A, int lda, const bf16_t* __restrict__ Bt, int ldb,
                                          int nk, Smem& sm, f32x16 (&acc)[2][2]) {
  const int t = tid__, lr = t >> 3, lc = t & 7;
  const bf16_t* ga = A + (size_t)lr * lda + lc * 8;
  const bf16_t* gb = Bt + (size_t)lr * ldb + lc * 8;
  const int sidx = lds_idx(lr, lc);
  Stage8 r0 = g_load(ga, gb, lda, ldb, 0);
  Stage8 r1 = g_load(ga, gb, lda, ldb, 1);
  g_store(r0, sm, 0, sidx);
  __syncthreads();
  for (int kt = 0; kt < nk - 2; kt += 2) {
    r0 = g_load(ga, gb, lda, ldb, kt + 2);
    compute_ktile(tid__, sm, 0, acc);
    g_store(r1, sm, 1, sidx);
    __syncthreads();
    r1 = g_load(ga, gb, lda, ldb, kt + 3);
    compute_ktile(tid__, sm, 1, acc);
    g_store(r0, sm, 0, sidx);
    __syncthreads();
  }
  compute_ktile(tid__, sm, 0, acc);
  g_store(r1, sm, 1, sidx);
  __syncthreads();
  compute_ktile(tid__, sm, 1, acc);
  __syncthreads();
}

template <class Epi>
__device__ __forceinline__ void gemm_phase(int tid__, const bf16_t* A, const bf16_t* Bt, int Mtiles, int NT, Smem& sm, Epi epi) {
  const int ntiles = Mtiles * NT;
  const int perm = (blockIdx.x & 7) * (gridDim.x >> 3) + (blockIdx.x >> 3);
  for (int base = 0; base < ntiles; base += gridDim.x) {
    const int v = base + perm;
    if (v >= ntiles) continue;
    int mt, nt;
    if (NT == 16) {
      const int half_tiles = Mtiles * 8, hf = v >= half_tiles ? 1 : 0, vv = v - hf * half_tiles;
      mt = vv >> 3; nt = hf * 8 + (vv & 7);
    } else { mt = v / NT; nt = v - mt * NT; }
    f32x16 acc[2][2];
#pragma unroll
    for (int mi = 0; mi < 2; ++mi)
#pragma unroll
      for (int ni = 0; ni < 2; ++ni)
#pragma unroll
        for (int r = 0; r < 16; ++r) acc[mi][ni][r] = 0.f;
    gemm_tile(tid__, A + (size_t)mt * 128 * DM, DM, Bt + (size_t)nt * 128 * DM, DM, 16, sm, acc);
    epi(acc, mt, nt);
    __syncthreads();
  }
}

__device__ __forceinline__ void cex_desc(uint32_t& a, uint32_t& b) { uint32_t mx = max(a, b), mn = min(a, b); a = mx; b = mn; }
__device__ __forceinline__ void sort16_desc(uint32_t (&v)[16]) {
#pragma unroll
  for (int k = 2; k <= 16; k <<= 1) {
#pragma unroll
    for (int j = k >> 1; j > 0; j >>= 1) {
#pragma unroll
      for (int i = 0; i < 16; ++i) {
        const int l = i ^ j;
        if (l > i) {
          if ((i & k) == 0) cex_desc(v[i], v[l]); else cex_desc(v[l], v[i]);
        }
      }
    }
  }
}
__device__ __forceinline__ void merge16_desc(uint32_t (&v)[16]) {
#pragma unroll
  for (int j = 8; j > 0; j >>= 1) {
#pragma unroll
    for (int i = 0; i < 16; ++i) {
      const int l = i ^ j;
      if (l > i) cex_desc(v[i], v[l]);
    }
  }
}

__device__ __forceinline__ void phase_setup(const Params& p, Smem& sm) {
  const int tid__ = tid_();
  const int tid = tid__, gtid = blockIdx.x * 256 + tid, gsz = gridDim.x * 256;
  {
    const size_t n16 = (size_t)4 * 16384 * 1024 / 16;
    for (int which = 0; which < 2; ++which) {
      const float4* src = (const float4*)p.in[which ? I_PV : I_PU];
      uint4* dst = (uint4*)(p.ws + (which ? OFF_PV : OFF_PU));
      const float sc = which ? 8.0f : 32.0f;
      for (size_t i = gtid; i < n16; i += gsz) {
        uint32_t o[4];
#pragma unroll
        for (int j = 0; j < 4; ++j) {
          const float4 a = src[4 * i + j];
          int w = 0;
          w = __builtin_amdgcn_cvt_pk_fp8_f32(a.x * sc, a.y * sc, w, false);
          w = __builtin_amdgcn_cvt_pk_fp8_f32(a.z * sc, a.w * sc, w, true);
          o[j] = (uint32_t)w;
        }
        const size_t e = i >> 6;
        const int piece = (int)(i & 63), slab = piece >> 3, sub = piece & 7;
        const size_t layer = e >> 14, ex = e & 16383;
        dst[((layer * 8 + slab) * 16384 + ex) * 8 + sub] = make_uint4(o[0], o[1], o[2], o[3]);
      }
    }
  }
  {
    for (int seg = 0; seg < 4; ++seg) {
      const int N = (seg == 0 || seg == 3) ? 2048 : 1024;
      const float* W = p.in[seg == 0 ? I_CMWIN : seg == 1 ? I_CMWOUT : seg == 2 ? I_SWIN : I_SWOUT];
      bf16_t* O = (bf16_t*)(p.ws + (seg == 0 ? OFF_WINC : seg == 1 ? OFF_WOUTC : seg == 2 ? OFF_WINS : OFF_WOUTS));
      const int total = 2 * N * 128;
      for (int i = gtid; i < total; i += gsz) {
        const int n = i % N, k8 = (i / N) % 128, m = i / (N * 128);
        int srcn = n;
        if (seg == 3) { const int tt = n >> 6, c = n & 63; srcn = c < 32 ? tt * 32 + c : 1024 + tt * 32 + (c - 32); }
        const float* s = W + (size_t)m * 1024 * N + (size_t)k8 * 8 * N + srcn;
        float f[8];
#pragma unroll
        for (int j = 0; j < 8; ++j) f[j] = s[(size_t)j * N];
        uint4 o; o.x = pack_bf16(f[0], f[1]); o.y = pack_bf16(f[2], f[3]); o.z = pack_bf16(f[4], f[5]); o.w = pack_bf16(f[6], f[7]);
        *(uint4*)(O + (size_t)m * N * 1024 + (size_t)n * 1024 + k8 * 8) = o;
      }
    }
    {
      const float4* src = (const float4*)p.in[I_CMWS];
      uint4* dst = (uint4*)(p.ws + OFF_WS);
      const int n8 = 2 * 8 * 128 * 128 / 8;
      for (int i = gtid; i < n8; i += gsz) {
        float4 a = src[2 * i], b = src[2 * i + 1];
        uint4 o; o.x = pack_bf16(a.x, a.y); o.y = pack_bf16(a.z, a.w); o.z = pack_bf16(b.x, b.y); o.w = pack_bf16(b.z, b.w);
        dst[i] = o;
      }
    }
  }
  {
    float* pe = (float*)(p.ws + OFF_PE);
    for (int i = gtid; i < 192 * 512; i += gsz) {
      const int pr = i >> 9, dd = i & 511, j = dd & 255;
      const float pos = (float)(pr < 128 ? pr : pr - 128);
      const float omega = 1.0f / powf(10000.0f, (float)j / 256.0f);
      const float ang = pos * omega;
      pe[i] = dd < 256 ? sinf(ang) : cosf(ang);
    }
  }
  {
    const int lane = tid & 63, gw = blockIdx.x * 4 + (tid >> 6), nw = gridDim.x * 4;
    bf16_t* weff = (bf16_t*)(p.ws + OFF_WEFF);
    for (int wt = gw; wt < 8192; wt += nw) {
      const int l = wt >> 11, rem = wt & 2047, hk = rem >> 7, mb = (rem >> 5) & 3, db = rem & 31;
      const float* ap = p.in[I_PWQ] + (size_t)l * 1024 * 4096 + (size_t)(db * 32 + (lane & 31)) * 4096 + hk * 256 + (lane >> 5) * 128;
      const float* bp = p.in[I_PKEYS] + ((size_t)(l * 16 + hk) * 128 + mb * 32 + (lane & 31)) * 256 + (lane >> 5) * 128;
      f32x16 acc;
#pragma unroll
      for (int r = 0; r < 16; ++r) acc[r] = 0.f;
      for (int s = 0; s < 128; s += 4) {
        const float4 av = *(const float4*)(ap + s), bv = *(const float4*)(bp + s);
        acc = __builtin_amdgcn_mfma_f32_32x32x2f32(av.x, bv.x, acc, 0, 0, 0);
        acc = __builtin_amdgcn_mfma_f32_32x32x2f32(av.y, bv.y, acc, 0, 0, 0);
        acc = __builtin_amdgcn_mfma_f32_32x32x2f32(av.z, bv.z, acc, 0, 0, 0);
        acc = __builtin_amdgcn_mfma_f32_32x32x2f32(av.w, bv.w, acc, 0, 0, 0);
      }
      bf16_t* o = weff + ((size_t)l * 2048 + hk * 128 + mb * 32 + (lane & 31)) * 1024 + db * 32 + 4 * (lane >> 5);
#pragma unroll
      for (int g = 0; g < 4; ++g) {
        uint2 v; v.x = pack_bf16(acc[4 * g], acc[4 * g + 1]); v.y = pack_bf16(acc[4 * g + 2], acc[4 * g + 3]);
        *(uint2*)(o + 8 * g) = v;
      }
    }
  }
  {
    float* sbuf = (float*)&sm;
    float* modp = (float*)(p.ws + OFF_MODP);
    for (int it = blockIdx.x; it < 4 * 24 * 8; it += gridDim.x) {
      const int l = it / 192, nb = (it / 8) % 24, sl = it & 7;
      __syncthreads();
      for (int i = tid; i < 9 * 128; i += 256) {
        const int r = i >> 7, d = sl * 128 + (i & 127);
        const float cv = r < 8 ? p.in[I_C][r * 1024 + d] : p.in[I_CCTX][d];
        sbuf[i] = siluf_(cv);
      }
      __syncthreads();
      const int n = nb * 256 + tid;
      const float* w = p.in[I_ADAW] + (size_t)l * 1024 * 6144 + (size_t)sl * 128 * 6144 + n;
      float acc[9];
#pragma unroll
      for (int r = 0; r < 9; ++r) acc[r] = 0.f;
      for (int d = 0; d < 128; ++d) {
        const float wv = w[(size_t)d * 6144];
#pragma unroll
        for (int r = 0; r < 9; ++r) acc[r] += sbuf[r * 128 + d] * wv;
      }
#pragma unroll
      for (int r = 0; r < 9; ++r) modp[((size_t)(l * 8 + sl) * 9 + r) * 6144 + n] = acc[r];
    }
    __syncthreads();
  }
}

__device__ __forceinline__ void phase_modfin(const Params& p) {
  const int tid__ = tid_();
  const int gtid = blockIdx.x * 256 + tid__, gsz = gridDim.x * 256;
  const float* modp = (const float*)(p.ws + OFF_MODP);
  float* mod = (float*)(p.ws + OFF_MOD);
  for (int i = gtid; i < 4 * 9 * 6144; i += gsz) {
    const int n = i % 6144, r = (i / 6144) % 9, l = i / (9 * 6144);
    float s = p.in[I_ADAB][l * 6144 + n];
#pragma unroll
    for (int sl = 0; sl < 8; ++sl) s += modp[((size_t)(l * 8 + sl) * 9 + r) * 6144 + n];
    mod[i] = s;
  }
}

__device__ __forceinline__ void load_row16(const float* src, int lane, float (&v)[16]) {
  const float4* s = (const float4*)src + lane * 4;
  float4 a = s[0], b = s[1], c = s[2], d = s[3];
  v[0] = a.x; v[1] = a.y; v[2] = a.z; v[3] = a.w; v[4] = b.x; v[5] = b.y; v[6] = b.z; v[7] = b.w;
  v[8] = c.x; v[9] = c.y; v[10] = c.z; v[11] = c.w; v[12] = d.x; v[13] = d.y; v[14] = d.z; v[15] = d.w;
}
__device__ __forceinline__ void store_row16(float* dst, int lane, const float (&v)[16]) {
  float4* s = (float4*)dst + lane * 4;
  s[0] = make_float4(v[0], v[1], v[2], v[3]); s[1] = make_float4(v[4], v[5], v[6], v[7]);
  s[2] = make_float4(v[8], v[9], v[10], v[11]); s[3] = make_float4(v[12], v[13], v[14], v[15]);
}
__device__ __forceinline__ void norm_mod_store(const float (&x)[16], const float* g, const float* sh, const float* sc, bf16_t* dst, int lane,
                                               uint8_t* dst8 = nullptr) {
  float ss = 0.f;
#pragma unroll
  for (int i = 0; i < 16; ++i) ss += x[i] * x[i];
  ss = wave_sum(ss);
  const float rstd = rsqrtf(ss * (1.0f / 1024.0f) + 1e-6f);
  float gv[16], sv[16], cv[16];
  load_row16(g, lane, gv); load_row16(sh, lane, sv); load_row16(sc, lane, cv);
  float y[16];
#pragma unroll
  for (int i = 0; i < 16; ++i) y[i] = x[i] * rstd * gv[i] * (1.0f + cv[i]) + sv[i];
  uint4 o0, o1;
  o0.x = pack_bf16(y[0], y[1]); o0.y = pack_bf16(y[2], y[3]); o0.z = pack_bf16(y[4], y[5]); o0.w = pack_bf16(y[6], y[7]);
  o1.x = pack_bf16(y[8], y[9]); o1.y = pack_bf16(y[10], y[11]); o1.z = pack_bf16(y[12], y[13]); o1.w = pack_bf16(y[14], y[15]);
  ((uint4*)dst)[2 * lane] = o0; ((uint4*)dst)[2 * lane + 1] = o1;
  if (dst8) {
    uint32_t w[4];
#pragma unroll
    for (int j = 0; j < 4; ++j) {
      int t = 0;
      t = __builtin_amdgcn_cvt_pk_fp8_f32(y[4 * j], y[4 * j + 1], t, false);
      t = __builtin_amdgcn_cvt_pk_fp8_f32(y[4 * j + 2], y[4 * j + 3], t, true);
      w[j] = (uint32_t)t;
    }
    ((uint4*)dst8)[lane] = make_uint4(w[0], w[1], w[2], w[3]);
  }
}


__device__ __forceinline__ void row_norm_pass(const Params& p, int tid__, int M, const float* g, const float* modl, int off_sh, int off_sc) {
  const int lane = tid__ & 63, gw = blockIdx.x * 4 + (tid__ >> 6), nw = gridDim.x * 4;
  bf16_t* xn = (bf16_t*)(p.ws + OFF_XN);
  if (gw >= M) return;
  float gv[16], w1[16], sh[16];
  load_row16(g, lane, gv);
  int cb = -1;
  float xnext[16];
  load_row16(xrow_ptr(p, gw), lane, xnext);
  uint4 po0 = make_uint4(0u, 0u, 0u, 0u), po1 = po0;
  int prow = gw;
  for (int row = gw; row < M; row += nw) {
    float x[16];
#pragma unroll
    for (int i = 0; i < 16; ++i) x[i] = xnext[i];
    float ss = 0.f;
#pragma unroll
    for (int i = 0; i < 16; ++i) ss += x[i] * x[i];
    __builtin_amdgcn_sched_barrier(0);
    {
      uint4* d = (uint4*)(xn + (size_t)prow * DM);
      st_nt_u4(d + 2 * lane, po0); st_nt_u4(d + 2 * lane + 1, po1);
      load_row16(xrow_ptr(p, row + nw < M ? row + nw : row), lane, xnext);
    }
    __builtin_amdgcn_sched_barrier(0);
    const int b = row_batch(row);
    if (b != cb) {
      cb = b;
      float cv[16];
      load_row16(modl + (size_t)b * 6144 + off_sc, lane, cv);
      load_row16(modl + (size_t)b * 6144 + off_sh, lane, sh);
#pragma unroll
      for (int i = 0; i < 16; ++i) w1[i] = gv[i] * (1.0f + cv[i]);
    }
    ss = wave_sum(ss);
    const float rstd = rsqrtf(ss * (1.0f / 1024.0f) + 1e-6f);
    float y[16];
#pragma unroll
    for (int i = 0; i < 16; ++i) y[i] = x[i] * rstd * w1[i] + sh[i];
    po0.x = pack_bf16(y[0], y[1]); po0.y = pack_bf16(y[2], y[3]); po0.z = pack_bf16(y[4], y[5]); po0.w = pack_bf16(y[6], y[7]);
    po1.x = pack_bf16(y[8], y[9]); po1.y = pack_bf16(y[10], y[11]); po1.z = pack_bf16(y[12], y[13]); po1.w = pack_bf16(y[14], y[15]);
    prow = row;
  }
  uint4* d = (uint4*)(xn + (size_t)prow * DM);
  st_nt_u4(d + 2 * lane, po0); st_nt_u4(d + 2 * lane + 1, po1);
}
__device__ __forceinline__ void phase_first_norm(const Params& p) {
  const int tid__ = tid_();
  const int lane = tid__ & 63, gw = blockIdx.x * 4 + (tid__ >> 6), nw = gridDim.x * 4;
  const float* pe = (const float*)(p.ws + OFF_PE);
  const float* mod = (const float*)(p.ws + OFF_MOD);
  bf16_t* xn = (bf16_t*)(p.ws + OFF_XN);
  for (int row = gw; row < TT; row += nw) {
    float x[16];
    if (row < TL) {
      load_row16(p.in[I_X] + (size_t)row * DM, lane, x);
      const int tkn = row & 8191, gr = tkn >> 6, gc = tkn & 63;
      const float* pp = lane < 32 ? pe + gr * 512 + 16 * lane : pe + (128 + gc) * 512 + 16 * lane - 512;
      float pv[16];
      load_row16(pp - 16 * lane, lane, pv);
#pragma unroll
      for (int i = 0; i < 16; ++i) x[i] += pv[i];
    } else {
      load_row16(p.in[I_CTX] + (size_t)(row - TL) * DM, lane, x);
    }
    store_row16(xrow_ptr(p, row), lane, x);
    const float* m = mod + (size_t)(0 * 9 + row_batch(row)) * 6144;
    norm_mod_store(x, p.in[I_N1G], m, m + 1024, xn + (size_t)row * DM, lane);
  }
}

__device__ __forceinline__ void phase_norm2(const Params& p, int l, int M) {
  const int tid__ = tid_();
  row_norm_pass(p, tid__, M, p.in[I_N2G] + l * 1024, (const float*)(p.ws + OFF_MOD) + (size_t)l * 9 * 6144, 3072, 4096);
}

__device__ __forceinline__ void phase_cm_in(const Params& p, int k, Smem& sm) {
  const int tid__ = tid_();
  bf16_t* Z = (bf16_t*)(p.ws + OFF_BUF1);
  float* part = (float*)(p.ws + OFF_PART);
  const int lane = tid__ & 63, w = tid__ >> 6, wr = w >> 1, wc = w & 1;
  gemm_phase(tid__, (const bf16_t*)(p.ws + OFF_XN), (const bf16_t*)(p.ws + OFF_WINC) + (size_t)k * 2048 * 1024, TT / 128, 16, sm,
    [&](f32x16 (&acc)[2][2], int mt, int nt) {
#pragma unroll
      for (int mi = 0; mi < 2; ++mi) {
        const int row = mt * 128 + wr * 64 + mi * 32 + (lane & 31);
        float s = 0.f, s2 = 0.f;
#pragma unroll
        for (int ni = 0; ni < 2; ++ni) {
          const int col = nt * 128 + wc * 64 + ni * 32 + 4 * (lane >> 5);
#pragma unroll
          for (int g = 0; g < 4; ++g) {
            float v0 = gelu_tanh(acc[mi][ni][4 * g]), v1 = gelu_tanh(acc[mi][ni][4 * g + 1]);
            float v2 = gelu_tanh(acc[mi][ni][4 * g + 2]), v3 = gelu_tanh(acc[mi][ni][4 * g + 3]);
            s += (v0 + v1) + (v2 + v3);
            s2 += (v0 * v0 + v1 * v1) + (v2 * v2 + v3 * v3);
            uint2 o; o.x = pack_bf16(v0, v1); o.y = pack_bf16(v2, v3);
            *(uint2*)(Z + (size_t)row * 2048 + col + 8 * g) = o;
          }
        }
        if (nt >= 8) {
          s += __shfl_xor(s, 32); s2 += __shfl_xor(s2, 32);
          if (lane < 32) *(float2*)(part + (size_t)row * 32 + ((nt - 8) * 2 + wc) * 2) = make_float2(s, s2);
        }
      }
    });
}

constexpr int STG_ROWB = 272;
__device__ __forceinline__ void phase_cm_gate(const Params& p, int k, Smem& sm) {
  const int tid__ = tid_();
  __shared__ float stat[128][2];
  const bf16_t* Z = (const bf16_t*)(p.ws + OFF_BUF1);
  bf16_t* UV = (bf16_t*)(p.ws + OFF_BUF2);
  const float* part = (const float*)(p.ws + OFF_PART);
  const bf16_t* WSb = (const bf16_t*)(p.ws + OFF_WS) + (size_t)k * 8 * 128 * 128;
  const float* lng = p.in[I_CMLNG] + k * 1024;
  const float* lnb = p.in[I_CMLNB] + k * 1024;
  const float* bs = p.in[I_CMBS] + k * 8 * 128;
  const int t = tid__, lane = t & 63, w = t >> 6, wr = w >> 1, wc = w & 1;
  const int ntiles = (TT / 128) * 8;
  for (int tile = blockIdx.x; tile < ntiles; tile += gridDim.x) {
    const int c = tile >> 3, h = tile & 7;
    if (t < 128) {
      const float4* pp = (const float4*)(part + (size_t)(c * 128 + t) * 32);
      float s = 0.f, s2 = 0.f;
#pragma unroll
      for (int i = 0; i < 8; ++i) { float4 v = pp[i]; s += v.x + v.z; s2 += v.y + v.w; }
      const float mu = s * (1.0f / 1024.0f);
      const float var = fmaxf(s2 * (1.0f / 1024.0f) - mu * mu, 0.f);
      stat[t][0] = mu; stat[t][1] = rsqrtf(var + 1e-6f);
    }
    {
      const int lr = t >> 3, lc = t & 7;
      const bf16_t* ga = WSb + (size_t)h * 128 * 128 + (size_t)lr * 128 + lc * 8;
#pragma unroll
      for (int kt = 0; kt < 2; ++kt)
#pragma unroll
        for (int i = 0; i < 4; ++i)
          sm.a[kt][lds_idx(lr + 32 * i, lc)] = *(const uint4*)(ga + (size_t)i * 32 * 128 + kt * 64);
    }
    {
      const int c16 = t & 15, d0 = c16 * 8;
      uint4 raw[8];
#pragma unroll
      for (int i = 0; i < 8; ++i) raw[i] = *(const uint4*)(Z + (size_t)(c * 128 + (t >> 4) + 16 * i) * 2048 + 1024 + h * 128 + d0);
      const float4 g0 = *(const float4*)(lng + h * 128 + d0), g1 = *(const float4*)(lng + h * 128 + d0 + 4);
      const float4 b0 = *(const float4*)(lnb + h * 128 + d0), b1 = *(const float4*)(lnb + h * 128 + d0 + 4);
      const float gg[8] = {g0.x, g0.y, g0.z, g0.w, g1.x, g1.y, g1.z, g1.w};
      const float bb[8] = {b0.x, b0.y, b0.z, b0.w, b1.x, b1.y, b1.z, b1.w};
      __syncthreads();
#pragma unroll
      for (int i = 0; i < 8; ++i) {
        const int q = (t >> 4) + 16 * i, kq = q & 63;
        const float mu = stat[q][0], rstd = stat[q][1];
        bf16_t* bl = (bf16_t*)&sm.b[q >> 6][0];
        const uint32_t wv[4] = {raw[i].x, raw[i].y, raw[i].z, raw[i].w};
#pragma unroll
        for (int e = 0; e < 8; ++e) {
          const float v = (e & 1) ? bf_hi(wv[e >> 1]) : bf_lo(wv[e >> 1]);
          const float y = (v - mu) * rstd * gg[e] + bb[e];
          bl[(size_t)lds_idx(d0 + e, kq >> 3) * 8 + (kq & 7)] = (bf16_t)(pack_bf16(y, y) & 0xffff);
        }
      }
    }
    __syncthreads();
    f32x16 acc[2][2];
#pragma unroll
    for (int mi = 0; mi < 2; ++mi)
#pragma unroll
      for (int ni = 0; ni < 2; ++ni)
#pragma unroll
        for (int r = 0; r < 16; ++r) acc[mi][ni][r] = 0.f;
    compute_ktile(tid__, sm, 0, acc);
    compute_ktile(tid__, sm, 1, acc);
    __syncthreads();
    {
      unsigned char* l = (unsigned char*)&sm;
#pragma unroll
      for (int mi = 0; mi < 2; ++mi) {
        const int pl = wr * 64 + mi * 32 + (lane & 31);
        const float bsv = bs[h * 128 + pl];
#pragma unroll
        for (int ni = 0; ni < 2; ++ni) {
          const int col = wc * 64 + ni * 32 + 4 * (lane >> 5);
#pragma unroll
          for (int g = 0; g < 4; ++g) {
            uint2 o; o.x = pack_bf16(acc[mi][ni][4 * g] + bsv, acc[mi][ni][4 * g + 1] + bsv);
            o.y = pack_bf16(acc[mi][ni][4 * g + 2] + bsv, acc[mi][ni][4 * g + 3] + bsv);
            *(uint2*)(l + pl * STG_ROWB + (col + 8 * g) * 2) = o;
          }
        }
      }
      __syncthreads();
#pragma unroll
      for (int i = 0; i < 8; ++i) {
        const int r = (t >> 4) + 16 * i, c8 = t & 15;
        const size_t row = (size_t)c * 128 + r;
        const uint4 gv = *(const uint4*)(l + r * STG_ROWB + c8 * 16);
        const uint4 uu = *(const uint4*)(Z + row * 2048 + h * 128 + c8 * 8);
        const uint32_t a[4] = {gv.x, gv.y, gv.z, gv.w}, b[4] = {uu.x, uu.y, uu.z, uu.w};
        uint32_t o[4];
#pragma unroll
        for (int j = 0; j < 4; ++j) o[j] = pack_bf16(bf_lo(a[j]) * bf_lo(b[j]), bf_hi(a[j]) * bf_hi(b[j]));
        st_nt_u4(UV + row * 1024 + h * 128 + c8 * 8, make_uint4(o[0], o[1], o[2], o[3]));
      }
    }
    __syncthreads();
  }
}

__device__ __forceinline__ void phase_cm_out(const Params& p, int l, int k, Smem& sm) {
  const int tid__ = tid_();
  const float* mod = (const float*)(p.ws + OFF_MOD);
  const int lane = tid__ & 63, w = tid__ >> 6, wr = w >> 1, wc = w & 1;
  gemm_phase(tid__, (const bf16_t*)(p.ws + OFF_BUF2), (const bf16_t*)(p.ws + OFF_WOUTC) + (size_t)k * 1024 * 1024, TT / 128, 8, sm,
    [&](f32x16 (&acc)[2][2], int mt, int nt) {
      const float* g1 = mod + (size_t)(l * 9 + row_batch(mt * 128)) * 6144 + 2048;
#pragma unroll
      for (int mi = 0; mi < 2; ++mi) {
        const int row = mt * 128 + wr * 64 + mi * 32 + (lane & 31);
        float* xr = xrow_ptr(p, row);
#pragma unroll
        for (int ni = 0; ni < 2; ++ni) {
          const int col = nt * 128 + wc * 64 + ni * 32 + 4 * (lane >> 5);
#pragma unroll
          for (int g = 0; g < 4; ++g) {
            float4 xv = *(float4*)(xr + col + 8 * g);
            const float4 gv = *(const float4*)(g1 + col + 8 * g);
            xv.x += gv.x * acc[mi][ni][4 * g]; xv.y += gv.y * acc[mi][ni][4 * g + 1];
            xv.z += gv.z * acc[mi][ni][4 * g + 2]; xv.w += gv.w * acc[mi][ni][4 * g + 3];
            *(float4*)(xr + col + 8 * g) = xv;
          }
        }
      }
    });
}

__device__ __forceinline__ void phase_ssm_in(const Params& p, int k, Smem& sm) {
  const int tid__ = tid_();
  bf16_t* U = (bf16_t*)(p.ws + OFF_BUF2);
  const int lane = tid__ & 63, w = tid__ >> 6, wr = w >> 1, wc = w & 1;
  gemm_phase(tid__, (const bf16_t*)(p.ws + OFF_XN), (const bf16_t*)(p.ws + OFF_WINS) + (size_t)k * 1024 * 1024, TT / 128, 8, sm,
    [&](f32x16 (&acc)[2][2], int mt, int nt) {
#pragma unroll
      for (int mi = 0; mi < 2; ++mi) {
        const int row = mt * 128 + wr * 64 + mi * 32 + (lane & 31);
#pragma unroll
        for (int ni = 0; ni < 2; ++ni) {
          const int col = nt * 128 + wc * 64 + ni * 32 + 4 * (lane >> 5);
#pragma unroll
          for (int g = 0; g < 4; ++g) {
            const int cc = col + 8 * g, grp = cc >> 4, ch = cc & 15;
            uint2 o; o.x = pack_bf16(acc[mi][ni][4 * g], acc[mi][ni][4 * g + 1]); o.y = pack_bf16(acc[mi][ni][4 * g + 2], acc[mi][ni][4 * g + 3]);
            *(uint2*)(U + ((size_t)grp * TT + row) * 16 + ch) = o;
          }
        }
      }
    });
}

constexpr int SCAN_ROWB = 272;
constexpr int SCAN_WAVE_LDS = 32 * SCAN_ROWB;
__device__ __forceinline__ void scan_item(int tid__, const Params& p, int k, int item, unsigned char* lds) {
  const int lane = tid__ & 63;
  const int dir = item & 1, g = (item >> 1) & 63, b = item >> 7;
  const bf16_t* U = (const bf16_t*)(p.ws + OFF_BUF2) + (size_t)g * TT * 16;
  bf16_t* Y = (bf16_t*)(p.ws + OFF_BUF1) + (size_t)dir * TT * 1024 + (size_t)g * TT * 16;
  const int pbase = ((k * 2 + dir) * 64 + g) * 64;
  const float step = expf(p.in[I_LSTEP][(k * 2 + dir) * 64 + g]);
  float ar, ai;
  {
    const float lr = p.in[I_LRE][pbase + lane], li = p.in[I_LIM][pbase + lane];
    const float mag = expf(lr * step);
    ar = mag * cosf(li * step); ai = mag * sinf(li * step);
  }
  bf16x8 bfrag[4];
#pragma unroll
  for (int hb = 0; hb < 2; ++hb) {
    const int pp = hb * 32 + (lane & 31);
    const float lr = p.in[I_LRE][pbase + pp], li = p.in[I_LIM][pbase + pp];
    const float mag = expf(lr * step);
    const float a_r = mag * cosf(li * step), a_i = mag * sinf(li * step);
    const float den = lr * lr + li * li;
    const float cr = ((a_r - 1.0f) * lr + a_i * li) / den;
    const float ci = (a_i * lr - (a_r - 1.0f) * li) / den;
    const float* bre = p.in[I_BRE] + (size_t)(pbase + pp) * 16 + 8 * (lane >> 5);
    const float* bim = p.in[I_BIM] + (size_t)(pbase + pp) * 16 + 8 * (lane >> 5);
    float re[8], im[8];
#pragma unroll
    for (int j = 0; j < 8; ++j) { re[j] = cr * bre[j] - ci * bim[j]; im[j] = cr * bim[j] + ci * bre[j]; }
    uint4 vr, vi;
    vr.x = pack_bf16(re[0], re[1]); vr.y = pack_bf16(re[2], re[3]); vr.z = pack_bf16(re[4], re[5]); vr.w = pack_bf16(re[6], re[7]);
    vi.x = pack_bf16(im[0], im[1]); vi.y = pack_bf16(im[2], im[3]); vi.z = pack_bf16(im[4], im[5]); vi.w = pack_bf16(im[6], im[7]);
    bfrag[hb] = *(bf16x8*)&vr; bfrag[2 + hb] = *(bf16x8*)&vi;
  }
  bf16x8 cfrag[4];
  {
    const int cbase = (((k * 2 + dir) * 64 + g) * 16 + (lane & 15)) * 64;
#pragma unroll
    for (int ks = 0; ks < 4; ++ks) {
      const int p0 = 16 * ks + 4 * (lane >> 4);
      const float4 cr = *(const float4*)(p.in[I_CRE] + cbase + p0), ci = *(const float4*)(p.in[I_CIM] + cbase + p0);
      uint4 v; v.x = pack_bf16(cr.x, -ci.x); v.y = pack_bf16(cr.y, -ci.y); v.z = pack_bf16(cr.z, -ci.z); v.w = pack_bf16(cr.w, -ci.w);
      cfrag[ks] = *(bf16x8*)&v;
    }
  }
  float hr = 0.f, hi = 0.f;
  const int ctx0 = TL + b * 256, lat0 = b * 8192;
  auto chunk_r0 = [&](int ci) -> int {
    int base, len, cc;
    if (ci < 8) { base = ctx0; len = 256; cc = ci; } else { base = lat0; len = 8192; cc = ci - 8; }
    return dir == 0 ? base + cc * 32 : base + len - 32 * (cc + 1);
  };
  const int tau_l = lane & 31;
  uint4 unext;
  {
    const int r0 = chunk_r0(0);
    const int row = dir == 0 ? r0 + tau_l : r0 + 31 - tau_l;
    unext = *(const uint4*)(U + (size_t)row * 16 + 8 * (lane >> 5));
  }
  uint2 ypend[2] = {make_uint2(0u, 0u), make_uint2(0u, 0u)};
  size_t opend[2];
  {
    const int r0 = chunk_r0(0);
#pragma unroll
    for (int nb = 0; nb < 2; ++nb) {
      const int tau = nb * 16 + (lane & 15);
      opend[nb] = (size_t)(dir == 0 ? r0 + tau : r0 + 31 - tau) * 16 + 4 * (lane >> 4);
    }
  }
  for (int ci = 0; ci < 264; ++ci) {
    const int r0 = chunk_r0(ci);
    const uint4 ucur = unext;
    const bf16x8 afrag = *(const bf16x8*)&ucur;
    f32x16 bu[4];
#pragma unroll
    for (int nb = 0; nb < 4; ++nb) {
#pragma unroll
      for (int r = 0; r < 16; ++r) bu[nb][r] = 0.f;
      bu[nb] = __builtin_amdgcn_mfma_f32_32x32x16_bf16(afrag, bfrag[nb], bu[nb], 0, 0, 0);
    }
    __builtin_amdgcn_sched_barrier(0);
    {
      *(uint2*)(Y + opend[0]) = ypend[0];
      *(uint2*)(Y + opend[1]) = ypend[1];
      const int r1 = chunk_r0(ci + 1 < 264 ? ci + 1 : 263);
      const int row = dir == 0 ? r1 + tau_l : r1 + 31 - tau_l;
      unext = *(const uint4*)(U + (size_t)row * 16 + 8 * (lane >> 5));
    }
    __builtin_amdgcn_sched_barrier(0);
#pragma unroll
    for (int r = 0; r < 16; ++r) {
      auto s0 = __builtin_amdgcn_permlane32_swap(__float_as_uint(bu[0][r]), __float_as_uint(bu[1][r]), false, false);
      bu[0][r] = __uint_as_float(s0[0]); bu[1][r] = __uint_as_float(s0[1]);
      auto s1 = __builtin_amdgcn_permlane32_swap(__float_as_uint(bu[2][r]), __float_as_uint(bu[3][r]), false, false);
      bu[2][r] = __uint_as_float(s1[0]); bu[3][r] = __uint_as_float(s1[1]);
    }
    asm volatile("" ::: "memory");
#pragma unroll
    for (int tau = 0; tau < 32; ++tau) {
      const int hb = (tau >> 2) & 1, r = (tau & 3) + 4 * (tau >> 3);
      const float bre = hb ? bu[1][r] : bu[0][r], bim = hb ? bu[3][r] : bu[2][r];
      const float nr = fmaf(ar, hr, fmaf(-ai, hi, bre));
      const float ni = fmaf(ar, hi, fmaf(ai, hr, bim));
      hr = nr; hi = ni;
      *(uint32_t*)(lds + tau * SCAN_ROWB + lane * 4) = pack_bf16(hr, hi);
    }
    asm volatile("s_waitcnt lgkmcnt(0)" ::: "memory");
#pragma unroll
    for (int nb = 0; nb < 2; ++nb) {
      f32x4 y = {0.f, 0.f, 0.f, 0.f};
#pragma unroll
      for (int ks = 0; ks < 4; ++ks) {
        const uint4 hv = *(const uint4*)(lds + (nb * 16 + (lane & 15)) * SCAN_ROWB + ks * 64 + (lane >> 4) * 16);
        y = __builtin_amdgcn_mfma_f32_16x16x32_bf16(cfrag[ks], *(const bf16x8*)&hv, y, 0, 0, 0);
      }
      const int tau = nb * 16 + (lane & 15);
      const int row = dir == 0 ? r0 + tau : r0 + 31 - tau;
      ypend[nb].x = pack_bf16(y[0], y[1]); ypend[nb].y = pack_bf16(y[2], y[3]);
      opend[nb] = (size_t)row * 16 + 4 * (lane >> 4);
    }
    asm volatile("s_waitcnt lgkmcnt(0)" ::: "memory");
  }
  *(uint2*)(Y + opend[0]) = ypend[0];
  *(uint2*)(Y + opend[1]) = ypend[1];
}
__device__ __forceinline__ void phase_scan(const Params& p, int k, Smem& sm) {
  const int tid__ = tid_();
  const int w = tid__ >> 6;
  const int nact = gridDim.x < 256 ? gridDim.x : 256;
  const int ipb = (1024 + nact - 1) / nact;
  unsigned char* lds = (unsigned char*)&sm + (size_t)w * SCAN_WAVE_LDS;
  if ((int)blockIdx.x < nact) {
    for (int s = w; s < ipb; s += 4) {
      const int item = blockIdx.x * ipb + s;
      if (item < 1024) scan_item(tid__, p, k, item, lds);
    }
  }
}

__device__ __forceinline__ void phase_ssm_comb(const Params& p, int k) {
  const int tid__ = tid_();
  const bf16_t* U = (const bf16_t*)(p.ws + OFF_BUF2);
  const bf16_t* YF = (const bf16_t*)(p.ws + OFF_BUF1);
  const bf16_t* YB = YF + (size_t)TT * 1024;
  bf16_t* G = (bf16_t*)(p.ws + OFF_XN);
  const float* dsk = p.in[I_SD] + k * 1024;
  const int nblk = TT / 8;
  for (int rb = blockIdx.x; rb < nblk; rb += gridDim.x) {
#pragma unroll
    for (int it = 0; it < 4; ++it) {
      const int e = it * 256 + tid__;
      const int row = rb * 8 + (e >> 7), g = (e >> 1) & 63, half = e & 1;
      const size_t off = ((size_t)g * TT + row) * 16 + half * 8;
      const uint4 u = *(const uint4*)(U + off), yf = *(const uint4*)(YF + off), yb = *(const uint4*)(YB + off);
      const float4 d0 = *(const float4*)(dsk + g * 16 + half * 8), d1 = *(const float4*)(dsk + g * 16 + half * 8 + 4);
      const uint32_t uw[4] = {u.x, u.y, u.z, u.w}, fw[4] = {yf.x, yf.y, yf.z, yf.w}, bw[4] = {yb.x, yb.y, yb.z, yb.w};
      const float dd[8] = {d0.x, d0.y, d0.z, d0.w, d1.x, d1.y, d1.z, d1.w};
      uint32_t ow[4];
#pragma unroll
      for (int i = 0; i < 4; ++i) {
        const float a = gelu_tanh(bf_lo(fw[i]) + bf_lo(bw[i]) + dd[2 * i] * bf_lo(uw[i]));
        const float c = gelu_tanh(bf_hi(fw[i]) + bf_hi(bw[i]) + dd[2 * i + 1] * bf_hi(uw[i]));
        ow[i] = pack_bf16(a, c);
      }
      st_nt_u4(G + (size_t)row * 1024 + g * 16 + half * 8, make_uint4(ow[0], ow[1], ow[2], ow[3]));
    }
  }
}

__device__ __forceinline__ void phase_ssm_out(const Params& p, int l, int k, int M, Smem& sm) {
  const int tid__ = tid_();
  const float* mod = (const float*)(p.ws + OFF_MOD);
  const int lane = tid__ & 63, w = tid__ >> 6, wr = w >> 1, wc = w & 1;
  gemm_phase(tid__, (const bf16_t*)(p.ws + OFF_XN), (const bf16_t*)(p.ws + OFF_WOUTS) + (size_t)k * 2048 * 1024, M / 128, 16, sm,
    [&](f32x16 (&acc)[2][2], int mt, int nt) {
      const float* g1 = mod + (size_t)(l * 9 + row_batch(mt * 128)) * 6144 + 2048;
#pragma unroll
      for (int mi = 0; mi < 2; ++mi) {
        const int row = mt * 128 + wr * 64 + mi * 32 + (lane & 31);
        float* xr = xrow_ptr(p, row);
        const int col = (nt * 2 + wc) * 32 + 4 * (lane >> 5);
#pragma unroll
        for (int g = 0; g < 4; ++g) {
          float4 xv = *(float4*)(xr + col + 8 * g);
          const float4 gv = *(const float4*)(g1 + col + 8 * g);
          xv.x += gv.x * acc[mi][0][4 * g] * sigmoidf_(acc[mi][1][4 * g]);
          xv.y += gv.y * acc[mi][0][4 * g + 1] * sigmoidf_(acc[mi][1][4 * g + 1]);
          xv.z += gv.z * acc[mi][0][4 * g + 2] * sigmoidf_(acc[mi][1][4 * g + 2]);
          xv.w += gv.w * acc[mi][0][4 * g + 3] * sigmoidf_(acc[mi][1][4 * g + 3]);
          *(float4*)(xr + col + 8 * g) = xv;
        }
      }
    });
}

__device__ __forceinline__ void phase_peer_score(const Params& p, int l, int M, Smem& sm) {
  const int tid__ = tid_();
  uint32_t* topk = (uint32_t*)(p.ws + OFF_TOPK);
  const int lane = tid__ & 63, w = tid__ >> 6, wr = w >> 1, wc = w & 1;
  uint32_t* ks = (uint32_t*)&sm;
  gemm_phase(tid__, (const bf16_t*)(p.ws + OFF_XN), (const bf16_t*)(p.ws + OFF_WEFF) + (size_t)l * 2048 * 1024, M / 128, 16, sm,
    [&](f32x16 (&acc)[2][2], int mt, int nt) {
#pragma unroll
      for (int mi = 0; mi < 2; ++mi) {
        uint32_t va[16], vb[16];
#pragma unroll
        for (int r = 0; r < 16; ++r) {
          const int c0 = wc * 64 + 8 * (r >> 2) + 4 * (lane >> 5) + (r & 3);
          va[r] = (ord_key(acc[mi][0][r]) & ~0x7fu) | (uint32_t)(127 - c0);
          vb[r] = (ord_key(acc[mi][1][r]) & ~0x7fu) | (uint32_t)(127 - (c0 + 32));
        }
        sort16_desc(va); __builtin_amdgcn_sched_barrier(0); sort16_desc(vb); __builtin_amdgcn_sched_barrier(0);
        uint32_t m[16];
#pragma unroll
        for (int i = 0; i < 16; ++i) m[i] = max(va[i], vb[15 - i]);
        merge16_desc(m);
        uint32_t q[16];
#pragma unroll
        for (int i = 0; i < 16; ++i) q[i] = __shfl_xor(m[15 - i], 32);
#pragma unroll
        for (int i = 0; i < 16; ++i) m[i] = max(m[i], q[i]);
        merge16_desc(m);
        if (lane < 32) {
          uint4* dst = (uint4*)(ks + ((((wr * 2 + mi) * 2 + wc) * 32 + lane) * 16));
          dst[0] = make_uint4(m[0], m[1], m[2], m[3]); dst[1] = make_uint4(m[4], m[5], m[6], m[7]);
          dst[2] = make_uint4(m[8], m[9], m[10], m[11]); dst[3] = make_uint4(m[12], m[13], m[14], m[15]);
        }
        __builtin_amdgcn_sched_barrier(0);
      }
      __syncthreads();
      {
        const int mi = wc, rl = lane & 31;
        const uint4* la = (const uint4*)(ks + ((((wr * 2 + mi) * 2 + 0) * 32 + rl) * 16));
        const uint4* lb = (const uint4*)(ks + ((((wr * 2 + mi) * 2 + 1) * 32 + rl) * 16));
        uint32_t a[16], b[16];
#pragma unroll
        for (int i = 0; i < 4; ++i) {
          const uint4 x = la[i], y = lb[i];
          a[4 * i] = x.x; a[4 * i + 1] = x.y; a[4 * i + 2] = x.z; a[4 * i + 3] = x.w;
          b[4 * i] = y.x; b[4 * i + 1] = y.y; b[4 * i + 2] = y.z; b[4 * i + 3] = y.w;
        }
        uint32_t m[16];
#pragma unroll
        for (int i = 0; i < 16; ++i) m[i] = max(a[i], b[15 - i]);
        merge16_desc(m);
        if (lane < 32) {
          const int row = mt * 128 + wr * 64 + mi * 32 + rl;
          uint4* dst = (uint4*)(topk + (size_t)row * 256 + nt * 16);
          dst[0] = make_uint4(m[0], m[1], m[2], m[3]); dst[1] = make_uint4(m[4], m[5], m[6], m[7]);
          dst[2] = make_uint4(m[8], m[9], m[10], m[11]); dst[3] = make_uint4(m[12], m[13], m[14], m[15]);
        }
      }
    });
}

typedef float f32x2 __attribute__((ext_vector_type(2)));
typedef _Float16 f16x2 __attribute__((ext_vector_type(2)));
__device__ __forceinline__ void fp8x16_to_f32(const uint4& r, float (&f)[16]) {
  const uint32_t w[4] = {r.x, r.y, r.z, r.w};
#pragma unroll
  for (int j = 0; j < 4; ++j) {
    const f32x2 lo = __builtin_amdgcn_cvt_pk_f32_fp8((int)w[j], false), hi = __builtin_amdgcn_cvt_pk_f32_fp8((int)w[j], true);
    f[4 * j] = lo.x; f[4 * j + 1] = lo.y; f[4 * j + 2] = hi.x; f[4 * j + 3] = hi.y;
  }
}
__device__ __forceinline__ void peer_load4(const uint8_t* PU, const uint8_t* PV, uint32_t idsr, int bl, int lane, uint4 (&U)[4], uint4 (&V)[4]) {
#pragma unroll
  for (int e = 0; e < 4; ++e) {
    const uint32_t id = __builtin_amdgcn_readlane(idsr, bl + e);
    U[e] = ((const uint4*)(PU + (size_t)id * 1024))[lane];
    V[e] = ((const uint4*)(PV + (size_t)id * 1024))[lane];
  }
}
__device__ __forceinline__ void peer_comp4(const uint4 (&U)[4], const uint4 (&V)[4], const float (&hf)[16], float gwr, int bl, int lane, float (&acc)[16]) {
  float pd[4];
#pragma unroll
  for (int e = 0; e < 4; ++e) {
    float uf[16];
    fp8x16_to_f32(U[e], uf);
    float s0 = 0.f, s1 = 0.f;
#pragma unroll
    for (int i = 0; i < 8; ++i) { s0 = fmaf(hf[2 * i], uf[2 * i], s0); s1 = fmaf(hf[2 * i + 1], uf[2 * i + 1], s1); }
    pd[e] = s0 + s1;
  }
  float r2[2], r1;
#pragma unroll
  for (int j = 0; j < 2; ++j) {
    const float keep = (lane & 1) ? pd[2 * j + 1] : pd[2 * j], send = (lane & 1) ? pd[2 * j] : pd[2 * j + 1];
    r2[j] = keep + __shfl_xor(send, 1);
  }
  {
    const float keep = (lane & 2) ? r2[1] : r2[0], send = (lane & 2) ? r2[0] : r2[1];
    r1 = keep + __shfl_xor(send, 2);
  }
  r1 += __shfl_xor(r1, 4); r1 += __shfl_xor(r1, 8); r1 += __shfl_xor(r1, 16); r1 += __shfl_xor(r1, 32);
  const float wv = gelu_tanh(r1 * (1.0f / 32.0f)) * __shfl(gwr, bl + (lane & 3)) * (1.0f / 8.0f);
#pragma unroll
  for (int e = 0; e < 4; ++e) {
    const float we = __uint_as_float(__builtin_amdgcn_readlane(__float_as_uint(wv), e));
    float vf[16];
    fp8x16_to_f32(V[e], vf);
#pragma unroll
    for (int i = 0; i < 16; ++i) acc[i] = fmaf(we, vf[i], acc[i]);
  }
}
__device__ __forceinline__ void phase_peer_gather(const Params& p, int l, int M) {
  const int tid__ = tid_();
  const int lane = tid__ & 63, gw = blockIdx.x * 4 + (tid__ >> 6), nw = gridDim.x * 4;
  const uint32_t* topk = (const uint32_t*)(p.ws + OFF_TOPK);
  bf16_t* xn = (bf16_t*)(p.ws + OFF_XN);
  const uint8_t* PU = (const uint8_t*)(p.ws + OFF_PU) + (size_t)l * 16384 * 1024;
  const uint8_t* PV = (const uint8_t*)(p.ws + OFF_PV) + (size_t)l * 16384 * 1024;
  const float* mod = (const float*)(p.ws + OFF_MOD);
  int ic, jc; const bool valid = lane < 50;
  {
    const int c = lane;
    if (c < 16) { ic = 0; jc = c; } else if (c < 24) { ic = 1; jc = c - 16; } else if (c < 29) { ic = 2; jc = c - 24; }
    else if (c < 33) { ic = 3; jc = c - 29; } else if (c < 36) { ic = 4; jc = c - 33; }
    else if (c < 42) { ic = 5 + ((c - 36) >> 1); jc = (c - 36) & 1; } else { ic = 8 + (c - 42); jc = 0; }
    if (!valid) { ic = 0; jc = 0; }
  }
  for (int row = gw; row < M; row += nw) {
    const uint32_t* tk = topk + (size_t)row * 256;
    uint32_t ids0 = 0, ids1 = 0; float gw0 = 0.f, gw1 = 0.f;
#pragma unroll 1
    for (int h = 0; h < 8; ++h) {
      const uint32_t K1 = tk[(2 * h) * 16 + (lane & 15)], K2 = tk[(2 * h + 1) * 16 + (lane & 15)];
      const float s1 = ord_dec(__shfl(K1, ic) & ~0x7fu), s2 = ord_dec(__shfl(K2, jc) & ~0x7fu);
      const uint32_t flat = (uint32_t)(ic * 16 + jc);
      const uint32_t key = valid ? ((ord_key(s1 + s2) & ~0xffu) | (255u - flat)) : 0u;
      int rank = 0;
#pragma unroll
      for (int c = 0; c < 50; ++c) {
        const uint32_t kk = __builtin_amdgcn_readlane(key, c);
        rank += (kk > key) ? 1 : 0;
      }
      const uint32_t fsorted = __builtin_amdgcn_ds_permute(rank * 4, flat);
      const uint32_t fl = __shfl(fsorted, lane & 15);
      const uint32_t k1 = __shfl(K1, (int)(fl >> 4)), k2 = __shfl(K2, (int)(fl & 15));
      const float sc = ord_dec(k1 & ~0x7fu) + ord_dec(k2 & ~0x7fu);
      const uint32_t id = (127u - (k1 & 127u)) * 128u + (127u - (k2 & 127u));
      const float mx = __shfl(sc, 0);
      const float e = __expf(sc - mx);
      float se = e;
      se += __shfl_xor(se, 1); se += __shfl_xor(se, 2); se += __shfl_xor(se, 4); se += __shfl_xor(se, 8);
      const float gsm = e / se;
      if ((lane >> 4) == (h & 3)) { if (h < 4) { ids0 = id; gw0 = gsm; } else { ids1 = id; gw1 = gsm; } }
    }
    float hf[16];
    {
      const uint4 h0 = ((const uint4*)(xn + (size_t)row * DM))[2 * lane], h1 = ((const uint4*)(xn + (size_t)row * DM))[2 * lane + 1];
      const uint32_t hw[8] = {h0.x, h0.y, h0.z, h0.w, h1.x, h1.y, h1.z, h1.w};
#pragma unroll
      for (int i = 0; i < 8; ++i) { hf[2 * i] = bf_lo(hw[i]); hf[2 * i + 1] = bf_hi(hw[i]); }
    }
    float acc[16];
#pragma unroll
    for (int i = 0; i < 16; ++i) acc[i] = 0.f;
    uint4 U0[4], V0[4], U1[4], V1[4];
#if (DUP_MASK >> 8) & 1
    gw0 *= 0.5f; gw1 *= 0.5f;
#pragma unroll 1
    for (int rep = 0; rep < 2; ++rep) {
#endif
    peer_load4(PU, PV, ids0, 0, lane, U0, V0);
#pragma unroll 1
    for (int g2 = 0; g2 < 16; ++g2) {
      const int h = g2 >> 1, bl = (h & 3) * 16 + (g2 & 1) * 8;
      const uint32_t idsr = h < 4 ? ids0 : ids1;
      const float gwr = h < 4 ? gw0 : gw1;
      peer_load4(PU, PV, idsr, bl + 4, lane, U1, V1);
      peer_comp4(U0, V0, hf, gwr, bl, lane, acc);
      if (g2 < 15) {
        const int hn = (g2 + 1) >> 1, bn = (hn & 3) * 16 + ((g2 + 1) & 1) * 8;
        const uint32_t idn = hn < 4 ? ids0 : ids1;
        peer_load4(PU, PV, idn, bn, lane, U0, V0);
      }
      peer_comp4(U1, V1, hf, gwr, bl + 4, lane, acc);
    }
#if (DUP_MASK >> 8) & 1
    }
#endif
    float x[16], g2v[16];
    float* xr = xrow_ptr(p, row);
    load_row16(xr, lane, x);
    const int b = row_batch(row);
    load_row16(mod + (size_t)(l * 9 + b) * 6144 + 5120, lane, g2v);
#pragma unroll
    for (int i = 0; i < 16; ++i) x[i] += g2v[i] * acc[i];
    if (l < 3) {
      store_row16(xr, lane, x);
      const float* m = mod + (size_t)((l + 1) * 9 + b) * 6144;
      norm_mod_store(x, p.in[I_N1G] + (l + 1) * 1024, m, m + 1024, xn + (size_t)row * DM, lane);
    } else {
      float ss = 0.f;
#pragma unroll
      for (int i = 0; i < 16; ++i) ss += x[i] * x[i];
      ss = wave_sum(ss);
      const float rstd = rsqrtf(ss * (1.0f / 1024.0f) + 1e-6f);
      float fg[16];
      load_row16(p.in[I_FG], lane, fg);
#pragma unroll
      for (int i = 0; i < 16; ++i) x[i] = x[i] * rstd * fg[i];
      store_row16(xr, lane, x);
    }
  }
}


constexpr size_t OFF_PD  = OFF_BUF1;
constexpr size_t OFF_IDS = OFF_BUF2;
constexpr size_t OFF_GW  = OFF_IDS + (size_t)TT * 128 * 2;
constexpr size_t OFF_WW  = OFF_GW + (size_t)TT * 128 * 4;
static_assert(OFF_WW + (size_t)TT * 128 * 4 <= OFF_TOPK, "PEER scratch overflows BUF2");

template <int CTRL> __device__ __forceinline__ float dpp_f(float v) {
  return __uint_as_float((uint32_t)__builtin_amdgcn_update_dpp(0, (int)__float_as_uint(v), CTRL, 0xf, 0xf, true));
}

template <int CTRL> __device__ __forceinline__ uint32_t dpp_u(uint32_t v) {
  return (uint32_t)__builtin_amdgcn_update_dpp(0, (int)v, CTRL, 0xf, 0xf, true);
}
__device__ __forceinline__ uint32_t xor_lane(uint32_t x, int d, int lane) {
  switch (d) {
    case 1: return dpp_u<0xB1>(x);
    case 2: return dpp_u<0x4E>(x);
    case 4: return (uint32_t)__builtin_amdgcn_ds_swizzle((int)x, (4 << 10) | 0x1f);
    case 8: return (uint32_t)__builtin_amdgcn_ds_swizzle((int)x, (8 << 10) | 0x1f);
    case 16: return (uint32_t)__builtin_amdgcn_ds_swizzle((int)x, (16 << 10) | 0x1f);
    default: {
      auto r = __builtin_amdgcn_permlane32_swap(x, x, false, false);
      return lane < 32 ? r[1] : r[0];
    }
  }
}
__device__ __forceinline__ float xor_lane_f(float x, int d, int lane) { return __uint_as_float(xor_lane(__float_as_uint(x), d, lane)); }
__device__ __forceinline__ void phase_peer_combine(const Params& p, int M) {
  const int tid__ = tid_();
  const int lane = tid__ & 63, gw = blockIdx.x * 4 + (tid__ >> 6), nw = gridDim.x * 4;
  const uint32_t* topk = (const uint32_t*)(p.ws + OFF_TOPK);
  uint16_t* idsT = (uint16_t*)(p.ws + OFF_IDS);
  float* gwT = (float*)(p.ws + OFF_GW);
  int ic, jc; const bool valid = lane < 50;
  {
    const int c = lane;
    if (c < 16) { ic = 0; jc = c; } else if (c < 24) { ic = 1; jc = c - 16; } else if (c < 29) { ic = 2; jc = c - 24; }
    else if (c < 33) { ic = 3; jc = c - 29; } else if (c < 36) { ic = 4; jc = c - 33; }
    else if (c < 42) { ic = 5 + ((c - 36) >> 1); jc = (c - 36) & 1; } else { ic = 8 + (c - 42); jc = 0; }
    if (!valid) { ic = 0; jc = 0; }
  }
  const uint32_t flat = (uint32_t)(ic * 16 + jc);
  uint32_t KN[16];
  if (gw < M) {
#pragma unroll
    for (int i = 0; i < 16; ++i) KN[i] = topk[(size_t)gw * 256 + i * 16 + (lane & 15)];
  }
  for (int row = gw; row < M; row += nw) {
    uint32_t KC[16];
#pragma unroll
    for (int i = 0; i < 16; ++i) KC[i] = KN[i];
#pragma unroll
    for (int hg = 0; hg < 2; ++hg) {
      uint32_t K1[4], K2[4], key[4];
#pragma unroll
      for (int hh = 0; hh < 4; ++hh) {
        const int h = hg * 4 + hh;
        K1[hh] = KC[2 * h]; K2[hh] = KC[2 * h + 1];
      }
#pragma unroll
      for (int hh = 0; hh < 4; ++hh) {
        const float s1 = ord_dec(__shfl(K1[hh], ic) & ~0x7fu), s2 = ord_dec(__shfl(K2[hh], jc) & ~0x7fu);
        key[hh] = valid ? ((ord_key(s1 + s2) & ~0xffu) | (255u - flat)) : 0u;
      }
#pragma unroll
      for (int k = 2; k <= 64; k <<= 1) {
#pragma unroll
        for (int j = k >> 1; j > 0; j >>= 1) {
          const bool desc = (k == 64) ? true : ((lane & k) == 0);
          const bool lower = (lane & j) == 0;
          uint32_t pk[4];
#pragma unroll
          for (int hh = 0; hh < 4; ++hh) pk[hh] = xor_lane(key[hh], j, lane);
#pragma unroll
          for (int hh = 0; hh < 4; ++hh) {
            const uint32_t mx = max(key[hh], pk[hh]), mn = min(key[hh], pk[hh]);
            key[hh] = (desc == lower) ? mx : mn;
          }
        }
      }
      uint32_t k1[4], k2[4];
#pragma unroll
      for (int hh = 0; hh < 4; ++hh) {
        const uint32_t fl = 255u - (key[hh] & 255u);
        k1[hh] = __shfl(K1[hh], (int)(fl >> 4)); k2[hh] = __shfl(K2[hh], (int)(fl & 15));
      }
      float e[4], se[4];
#pragma unroll
      for (int hh = 0; hh < 4; ++hh) {
        const float sc = ord_dec(k1[hh] & ~0x7fu) + ord_dec(k2[hh] & ~0x7fu);
        const float mx = __uint_as_float(__builtin_amdgcn_readlane(__float_as_uint(sc), 0));
        e[hh] = __expf(sc - mx); se[hh] = e[hh];
      }
#pragma unroll
      for (int d = 1; d <= 8; d <<= 1) {
        float t4[4];
#pragma unroll
        for (int hh = 0; hh < 4; ++hh) t4[hh] = xor_lane_f(se[hh], d, lane);
#pragma unroll
        for (int hh = 0; hh < 4; ++hh) se[hh] += t4[hh];
      }
      if (lane < 16) {
#pragma unroll
        for (int hh = 0; hh < 4; ++hh) {
          const int h = hg * 4 + hh, k = lane, pos = (k & 7) * 16 + 2 * h + (k >> 3);
          const uint32_t id = (127u - (k1[hh] & 127u)) * 128u + (127u - (k2[hh] & 127u));
          idsT[(size_t)row * 128 + pos] = (uint16_t)id;
          gwT[(size_t)row * 128 + pos] = e[hh] / se[hh];
        }
      }
      if (hg == 0) {
        __builtin_amdgcn_sched_barrier(0);
        const uint32_t* tn = topk + (size_t)(row + nw < M ? row + nw : row) * 256 + (lane & 15);
#pragma unroll
        for (int i = 0; i < 16; ++i) KN[i] = tn[i * 16];
        __builtin_amdgcn_sched_barrier(0);
      }
    }
  }
}

typedef uint32_t u32x4v __attribute__((ext_vector_type(4)));
__device__ __forceinline__ uint4 ld_nt16(const void* p) { const u32x4v v = __builtin_nontemporal_load((const u32x4v*)p); return make_uint4(v.x, v.y, v.z, v.w); }
__device__ __forceinline__ float2 ld_nt8(const void* p) { const f32x2 v = __builtin_nontemporal_load((const f32x2*)p); return make_float2(v.x, v.y); }
__device__ __forceinline__ void st_nt8(void* p, float2 v) { const f32x2 t = {v.x, v.y}; __builtin_nontemporal_store(t, (f32x2*)p); }
__device__ __forceinline__ uint32_t peer_id16(const uint4& i0, const uint4& i1, int i) {
  const uint32_t iw[8] = {i0.x, i0.y, i0.z, i0.w, i1.x, i1.y, i1.z, i1.w};
  return (i & 1) ? (iw[i >> 1] >> 16) : (iw[i >> 1] & 0xffffu);
}
__device__ __forceinline__ void phase_peer_dots(const Params& p, int l, int M) {
  const int tid__ = tid_();
  const int lane = tid__ & 63, grp = lane >> 3, j = lane & 7;
  const int s = blockIdx.x & 7, worker = (blockIdx.x >> 3) * 4 + (tid__ >> 6), nworker = (gridDim.x >> 3) * 4;
  const uint16_t* idsT = (const uint16_t*)(p.ws + OFF_IDS) + grp * 16;
  const bf16_t* xn = (const bf16_t*)(p.ws + OFF_XN) + 128 * s + 16 * j;
  float* pd = (float*)(p.ws + OFF_PD) + (size_t)s * 128 + grp * 16 + 8 * (j & 1) + 4 * ((j >> 1) & 1) + 2 * (j >> 2);
  const uint8_t* PU = (const uint8_t*)(p.ws + OFF_PU) + ((size_t)l * 8 + s) * 16384 * 128 + 16 * j;
  const int last = M - 1;
  int row = worker;
  uint4 ia0 = *(const uint4*)(idsT + (size_t)row * 128), ia1 = *(const uint4*)(idsT + (size_t)row * 128 + 8);
  uint4 U[16];
#pragma unroll
  for (int i = 0; i < 16; ++i) U[i] = *(const uint4*)(PU + (size_t)peer_id16(ia0, ia1, i) * 128);
  uint4 h0 = *(const uint4*)(xn + (size_t)row * DM), h1 = *(const uint4*)(xn + (size_t)row * DM + 8);
  {
    const int rn = min(row + nworker, last);
    ia0 = *(const uint4*)(idsT + (size_t)rn * 128); ia1 = *(const uint4*)(idsT + (size_t)rn * 128 + 8);
  }
  for (; row < M; row += nworker) {
    const int rn = min(row + nworker, last), rnn = min(row + 2 * nworker, last);
    const uint4 ib0 = *(const uint4*)(idsT + (size_t)rnn * 128), ib1 = *(const uint4*)(idsT + (size_t)rnn * 128 + 8);
    const uint4 hn0 = *(const uint4*)(xn + (size_t)rn * DM), hn1 = *(const uint4*)(xn + (size_t)rn * DM + 8);
    f16x2 hh[8];
    {
      const uint32_t hw[8] = {h0.x, h0.y, h0.z, h0.w, h1.x, h1.y, h1.z, h1.w};
#pragma unroll
      for (int c = 0; c < 8; ++c) { hh[c].x = (_Float16)bf_lo(hw[c]); hh[c].y = (_Float16)bf_hi(hw[c]); }
    }
    float pp[16];
#pragma unroll
    for (int i = 0; i < 16; ++i) {
      const uint4 ur = U[i];
      U[i] = *(const uint4*)(PU + (size_t)peer_id16(ia0, ia1, i) * 128);
      const int uw[4] = {(int)ur.x, (int)ur.y, (int)ur.z, (int)ur.w};
      float sv = 0.f;
#pragma unroll
      for (int c = 0; c < 4; ++c) {
        sv = __builtin_amdgcn_fdot2(__builtin_bit_cast(f16x2, __builtin_amdgcn_cvt_scalef32_pk_f16_fp8(uw[c], 1.0f, false)), hh[2 * c], sv, false);
        sv = __builtin_amdgcn_fdot2(__builtin_bit_cast(f16x2, __builtin_amdgcn_cvt_scalef32_pk_f16_fp8(uw[c], 1.0f, true)), hh[2 * c + 1], sv, false);
      }
      pp[i] = sv;
      if ((i & 3) == 3) __builtin_amdgcn_sched_barrier(0);
    }
    float q[8], r[4], t2[2];
#pragma unroll
    for (int mm = 0; mm < 8; ++mm) {
      const float keep = (j & 1) ? pp[mm + 8] : pp[mm], send = (j & 1) ? pp[mm] : pp[mm + 8];
      q[mm] = keep + dpp_f<0xB1>(send);
    }
#pragma unroll
    for (int mm = 0; mm < 4; ++mm) {
      const float keep = (j & 2) ? q[mm + 4] : q[mm], send = (j & 2) ? q[mm] : q[mm + 4];
      r[mm] = keep + dpp_f<0x4E>(send);
    }
#pragma unroll
    for (int mm = 0; mm < 2; ++mm) {
      const float keep = (j & 4) ? r[mm + 2] : r[mm], send = (j & 4) ? r[mm] : r[mm + 2];
      t2[mm] = keep + __shfl_xor(send, 4);
    }
    st_nt8(pd + (size_t)row * 1024, make_float2(t2[0], t2[1]));
    ia0 = ib0; ia1 = ib1; h0 = hn0; h1 = hn1;
  }
}

__device__ __forceinline__ void phase_peer_weights(const Params& p, int M) {
  const int tid__ = tid_();
  const int lane = tid__ & 63, gw = blockIdx.x * 4 + (tid__ >> 6), nw = gridDim.x * 4;
  const float* pd = (const float*)(p.ws + OFF_PD) + 2 * lane;
  const float* gwT = (const float*)(p.ws + OFF_GW) + 2 * lane;
  _Float16* ww = (_Float16*)(p.ws + OFF_WW) + 2 * lane;
  if (gw >= M) return;
  float2 vn[8], gn;
#pragma unroll
  for (int s = 0; s < 8; ++s) vn[s] = *(const float2*)(pd + ((size_t)gw * 8 + s) * 128);
  gn = *(const float2*)(gwT + (size_t)gw * 128);
  f16x2 pw = {(_Float16)0.f, (_Float16)0.f};
  int prow = gw;
  for (int row = gw; row < M; row += nw) {
    float d0 = 0.f, d1 = 0.f;
#pragma unroll
    for (int s = 0; s < 8; ++s) { d0 += vn[s].x; d1 += vn[s].y; }
    const float2 g = gn;
    __builtin_amdgcn_sched_barrier(0);
    {
      *(f16x2*)(ww + (size_t)prow * 128) = pw;
      const int rn = row + nw < M ? row + nw : row;
#pragma unroll
      for (int s = 0; s < 8; ++s) vn[s] = *(const float2*)(pd + ((size_t)rn * 8 + s) * 128);
      gn = *(const float2*)(gwT + (size_t)rn * 128);
    }
    __builtin_amdgcn_sched_barrier(0);
    pw.x = (_Float16)(gelu_tanh(d0 * (1.0f / 32.0f)) * g.x * 32.0f);
    pw.y = (_Float16)(gelu_tanh(d1 * (1.0f / 32.0f)) * g.y * 32.0f);
    prow = row;
  }
  *(f16x2*)(ww + (size_t)prow * 128) = pw;
}

struct PeerMetaB { uint4 w0, w1; float2 x; };
__device__ __forceinline__ void phase_peer_values(const Params& p, int l, int M, bool dry) {
  const int tid__ = tid_();
  const int lane = tid__ & 63, grp = lane >> 3, j = lane & 7;
  const int s = blockIdx.x & 7, worker = (blockIdx.x >> 3) * 4 + (tid__ >> 6), nworker = (gridDim.x >> 3) * 4;
  const uint16_t* idsT = (const uint16_t*)(p.ws + OFF_IDS) + grp * 16;
  const _Float16* ww = (const _Float16*)(p.ws + OFF_WW) + grp * 16;
  const int col = 128 * s + 16 * j + 8 * ((lane >> 3) & 1) + 4 * ((lane >> 4) & 1) + 2 * ((lane >> 5) & 1);
  const float* mod = (const float*)(p.ws + OFF_MOD) + (size_t)l * 9 * 6144 + 5120 + col;
  const uint8_t* PV = (const uint8_t*)(p.ws + OFF_PV) + ((size_t)l * 8 + s) * 16384 * 128 + 16 * j;
  auto meta = [&](int r_) {
    PeerMetaB m;
    m.w0 = *(const uint4*)(ww + (size_t)r_ * 128); m.w1 = *(const uint4*)(ww + (size_t)r_ * 128 + 8);
    m.x = *(const float2*)(xrow_ptr(p, r_) + col);
    return m;
  };
  const int last = M - 1;
  int row = worker;
  uint4 ia0 = *(const uint4*)(idsT + (size_t)row * 128), ia1 = *(const uint4*)(idsT + (size_t)row * 128 + 8);
  uint4 V[16];
#pragma unroll
  for (int i = 0; i < 16; ++i) V[i] = *(const uint4*)(PV + (size_t)peer_id16(ia0, ia1, i) * 128);
  PeerMetaB m = meta(row);
  {
    const int rn = min(row + nworker, last);
    ia0 = *(const uint4*)(idsT + (size_t)rn * 128); ia1 = *(const uint4*)(idsT + (size_t)rn * 128 + 8);
  }
  int gb = -1; float2 g2v = make_float2(0.f, 0.f);
  for (; row < M; row += nworker) {
    const int rn = min(row + nworker, last), rnn = min(row + 2 * nworker, last);
    const uint4 ib0 = *(const uint4*)(idsT + (size_t)rnn * 128), ib1 = *(const uint4*)(idsT + (size_t)rnn * 128 + 8);
    const PeerMetaB mn = meta(rn);
    const int b = row_batch(row);
    if (b != gb) { gb = b; g2v = *(const float2*)(mod + (size_t)b * 6144); }
    const uint32_t wp[8] = {m.w0.x, m.w0.y, m.w0.z, m.w0.w, m.w1.x, m.w1.y, m.w1.z, m.w1.w};
    f16x2 acc2[8];
#pragma unroll
    for (int c = 0; c < 8; ++c) acc2[c] = (f16x2){(_Float16)0.f, (_Float16)0.f};
#pragma unroll
    for (int i = 0; i < 16; ++i) {
      const uint4 vr = V[i];
      V[i] = *(const uint4*)(PV + (size_t)peer_id16(ia0, ia1, i) * 128);
      const int vw[4] = {(int)vr.x, (int)vr.y, (int)vr.z, (int)vr.w};
      const f16x2 wpair = __builtin_bit_cast(f16x2, wp[i >> 1]);
      const _Float16 wh = (i & 1) ? wpair.y : wpair.x;
      const f16x2 w2 = {wh, wh};
#pragma unroll
      for (int c = 0; c < 4; ++c) {
        const f16x2 va = __builtin_bit_cast(f16x2, __builtin_amdgcn_cvt_scalef32_pk_f16_fp8(vw[c], 1.0f, false));
        const f16x2 vb = __builtin_bit_cast(f16x2, __builtin_amdgcn_cvt_scalef32_pk_f16_fp8(vw[c], 1.0f, true));
        acc2[2 * c] = __builtin_elementwise_fma(w2, va, acc2[2 * c]);
        acc2[2 * c + 1] = __builtin_elementwise_fma(w2, vb, acc2[2 * c + 1]);
      }
      if ((i & 3) == 3) __builtin_amdgcn_sched_barrier(0);
    }
    float acc[16];
#pragma unroll
    for (int c = 0; c < 8; ++c) { acc[2 * c] = (float)acc2[c].x * (1.0f / 256.0f); acc[2 * c + 1] = (float)acc2[c].y * (1.0f / 256.0f); }
    float q[8], r[4], t2[2];
#pragma unroll
    for (int mm = 0; mm < 8; ++mm) {
      const float keep = (lane & 8) ? acc[mm + 8] : acc[mm], send = (lane & 8) ? acc[mm] : acc[mm + 8];
      q[mm] = keep + dpp_f<0x128>(send);
    }
#pragma unroll
    for (int mm = 0; mm < 4; ++mm) {
      const float keep = (lane & 16) ? q[mm + 4] : q[mm], send = (lane & 16) ? q[mm] : q[mm + 4];
      r[mm] = keep + __shfl_xor(send, 16);
    }
#pragma unroll
    for (int mm = 0; mm < 2; ++mm) {
      const float keep = (lane & 32) ? r[mm + 2] : r[mm], send = (lane & 32) ? r[mm] : r[mm + 2];
      t2[mm] = keep + __shfl_xor(send, 32);
    }
    float* xr = dry ? (float*)(p.ws + OFF_PD) + (size_t)row * 1024 + col : xrow_ptr(p, row) + col;
    st_nt8(xr, make_float2(m.x.x + g2v.x * t2[0], m.x.y + g2v.y * t2[1]));
    ia0 = ib0; ia1 = ib1; m = mn;
  }
}

__device__ __forceinline__ void phase_next_norm(const Params& p, int l, int M) {
  const int tid__ = tid_();
  const int lane = tid__ & 63, gw = blockIdx.x * 4 + (tid__ >> 6), nw = gridDim.x * 4;
  const float* mod = (const float*)(p.ws + OFF_MOD);
  bf16_t* xn = (bf16_t*)(p.ws + OFF_XN);
  if (l < 3) {
    row_norm_pass(p, tid__, M, p.in[I_N1G] + (l + 1) * 1024, mod + (size_t)(l + 1) * 9 * 6144, 0, 1024);
    return;
  }
  for (int row = gw; row < M; row += nw) {
    float x[16];
    float* xr = xrow_ptr(p, row);
    load_row16(xr, lane, x);
    {
      float ss = 0.f;
#pragma unroll
      for (int i = 0; i < 16; ++i) ss += x[i] * x[i];
      ss = wave_sum(ss);
      const float rstd = rsqrtf(ss * (1.0f / 1024.0f) + 1e-6f);
      float fg[16];
      load_row16(p.in[I_FG], lane, fg);
#pragma unroll
      for (int i = 0; i < 16; ++i) x[i] = x[i] * rstd * fg[i];
      store_row16(xr, lane, x);
    }
  }
}


constexpr size_t OFF_BAR = OFF_HN8;
__device__ __forceinline__ void fast_grid_barrier(unsigned* bar, unsigned epoch, int tid) {
  asm volatile("s_waitcnt vmcnt(0)" ::: "memory");
  __syncthreads();
  if (tid == 0) {
    __builtin_amdgcn_fence(__ATOMIC_RELEASE, "agent");
    const unsigned g = blockIdx.x & 7u, per = gridDim.x >> 3;
    const unsigned v = __hip_atomic_fetch_add(bar + g * 64, 1u, __ATOMIC_RELAXED, __HIP_MEMORY_SCOPE_AGENT) + 1u;
    if (v == epoch * per) {
      const unsigned t = __hip_atomic_fetch_add(bar + 8 * 64, 1u, __ATOMIC_RELAXED, __HIP_MEMORY_SCOPE_AGENT) + 1u;
      if (t == epoch * 8u) __hip_atomic_store(bar + 9 * 64, epoch, __ATOMIC_RELAXED, __HIP_MEMORY_SCOPE_AGENT);
    }
    while (__hip_atomic_load(bar + 9 * 64, __ATOMIC_RELAXED, __HIP_MEMORY_SCOPE_AGENT) < epoch) __builtin_amdgcn_s_sleep(1);
    __builtin_amdgcn_fence(__ATOMIC_ACQUIRE, "agent");
  }
  __syncthreads();
}

#ifndef DUP_MASK
#define DUP_MASK 0
#endif
#define SYNC fast_grid_barrier(bar, ++epoch, btid);
#define RUN(K, CALL) { CALL; if ((DUP_MASK >> (K)) & 1) { grid.sync(); CALL; } }
#define PEER(L, MM) \
  RUN(3, phase_norm2(p, L, MM)) SYNC \
  RUN(4, phase_peer_score(p, L, MM, sm)) SYNC \
  RUN(8, phase_peer_combine(p, MM)) SYNC \
  RUN(9, phase_peer_dots(p, L, MM)) SYNC \
  RUN(10, phase_peer_weights(p, MM)) SYNC \
  if ((DUP_MASK >> 12) & 1) { phase_peer_values(p, L, MM, true); grid.sync(); } \
  phase_peer_values(p, L, MM, false); SYNC \
  RUN(11, phase_next_norm(p, L, MM))
__global__ void __launch_bounds__(256, 2) mega_kernel(Params p) {
  __shared__ Smem sm;
  cg::grid_group grid = cg::this_grid();
  unsigned* bar = (unsigned*)(p.ws + OFF_BAR);
  unsigned epoch = 0;
  const int btid = (int)__builtin_amdgcn_workitem_id_x();
  RUN(0, phase_setup(p, sm))
  grid.sync();
  RUN(0, phase_modfin(p)) SYNC
  RUN(15, phase_first_norm(p)) SYNC
  RUN(1, phase_cm_in(p, 0, sm)) SYNC
  RUN(2, phase_cm_gate(p, 0, sm)) SYNC
  RUN(15, phase_cm_out(p, 0, 0, sm)) SYNC
  PEER(0, TT) SYNC
  RUN(5, phase_ssm_in(p, 0, sm)) SYNC
  RUN(6, phase_scan(p, 0, sm)) SYNC
  RUN(7, phase_ssm_comb(p, 0)) SYNC
  RUN(15, phase_ssm_out(p, 1, 0, TT, sm)) SYNC
  PEER(1, TT) SYNC
  RUN(1, phase_cm_in(p, 1, sm)) SYNC
  RUN(2, phase_cm_gate(p, 1, sm)) SYNC
  RUN(15, phase_cm_out(p, 2, 1, sm)) SYNC
  PEER(2, TT) SYNC
  RUN(5, phase_ssm_in(p, 1, sm)) SYNC
  RUN(6, phase_scan(p, 1, sm)) SYNC
  RUN(7, phase_ssm_comb(p, 1)) SYNC
  RUN(15, phase_ssm_out(p, 3, 1, TL, sm)) SYNC
  PEER(3, TL)
}

extern "C" void kernel_launch(void* const* d_in, const int* in_sizes, int n_in, void* d_out, int out_size, void* d_ws, size_t ws_size,
                              hipStream_t stream) {
  static int grid_blocks = 0;
  if (!grid_blocks) {
    int dev = 0, cus = 0, per_cu = 0;
    hipGetDevice(&dev);
    hipDeviceGetAttribute(&cus, hipDeviceAttributeMultiprocessorCount, dev);
    hipOccupancyMaxActiveBlocksPerMultiprocessor(&per_cu, mega_kernel, 256, 0);
    if (per_cu > 2) per_cu = 2;
    if (per_cu < 1) per_cu = 1;
    grid_blocks = cus * per_cu;
    grid_blocks -= grid_blocks % 8;
  }
  if (ws_size < WS_TOTAL) { fprintf(stderr, "workspace too small: %zu < %zu\n", ws_size, (size_t)WS_TOTAL); return; }
  Params p{};
  for (int i = 0; i < 29; ++i) p.in[i] = (const float*)d_in[i];
  p.out = (float*)d_out;
  p.ws = (unsigned char*)d_ws;
  hipMemsetAsync((unsigned char*)d_ws + OFF_BAR, 0, 4096, stream);
  void* args[] = {&p};
  hipError_t e = hipLaunchCooperativeKernel((void*)mega_kernel, dim3(grid_blocks), dim3(256), args, 0, stream);
  if (e != hipSuccess) fprintf(stderr, "cooperative launch failed: %s (grid %d)\n", hipGetErrorString(e), grid_blocks);
}
```

```cpp
#include <hip/hip_runtime.h>
#include <hip/hip_cooperative_groups.h>
#include <stdint.h>
#include <cstdio>
namespace cg = cooperative_groups;

#ifndef MULTI_LAUNCH
#define MULTI_LAUNCH 0
#endif

typedef short bf16x8 __attribute__((ext_vector_type(8)));
typedef float f32x16 __attribute__((ext_vector_type(16)));
typedef float f32x4 __attribute__((ext_vector_type(4)));
typedef __bf16 bf2 __attribute__((ext_vector_type(2)));
typedef uint16_t bf16_t;

constexpr int TL = 65536, TC = 2048, TT = TL + TC, DM = 1024;
constexpr int NPHASE = 29;

constexpr size_t OFF_HC   = 0;
constexpr size_t OFF_MODP = OFF_HC   + (size_t)TC * DM * 4;
constexpr size_t OFF_MOD  = OFF_MODP + (size_t)4 * 8 * 9 * 6144 * 4;
constexpr size_t OFF_PE   = OFF_MOD  + (size_t)4 * 9 * 6144 * 4;
constexpr size_t OFF_PART = OFF_PE   + (size_t)192 * 512 * 4;
constexpr size_t OFF_XN   = OFF_PART + (size_t)TT * 32 * 4;
constexpr size_t OFF_BUF1 = OFF_XN   + (size_t)TT * DM * 2;
constexpr size_t OFF_BUF2 = OFF_BUF1 + (size_t)TT * 2048 * 2;
constexpr size_t OFF_TOPK = OFF_BUF2 + (size_t)TT * DM * 2;
constexpr size_t OFF_WINC = OFF_TOPK + (size_t)TT * 256 * 4;
constexpr size_t OFF_WOUTC= OFF_WINC + (size_t)2 * 2048 * 1024 * 2;
constexpr size_t OFF_WINS = OFF_WOUTC+ (size_t)2 * 1024 * 1024 * 2;
constexpr size_t OFF_WOUTS= OFF_WINS + (size_t)2 * 1024 * 1024 * 2;
constexpr size_t OFF_WEFF = OFF_WOUTS+ (size_t)2 * 2048 * 1024 * 2;
constexpr size_t OFF_WS   = OFF_WEFF + (size_t)4 * 2048 * 1024 * 2;
constexpr size_t OFF_PU   = OFF_WS   + (size_t)2 * 8 * 128 * 128 * 2;
constexpr size_t OFF_PV   = OFF_PU   + (size_t)4 * 16384 * 1024 * 2;
constexpr size_t OFF_HN8  = OFF_PV + (size_t)4 * 16384 * 1024;
constexpr size_t WS_TOTAL = OFF_HN8 + (size_t)TT * 1024;

struct Params {
  const float* in[29];
  float* out;
  unsigned char* ws;
};
enum { I_X = 0, I_C, I_CTX, I_CCTX, I_ADAW, I_ADAB, I_N1G, I_N2G, I_FG, I_CMWIN, I_CMLNG, I_CMLNB, I_CMWS, I_CMBS,
       I_CMWOUT, I_SWIN, I_LRE, I_LIM, I_LSTEP, I_BRE, I_BIM, I_CRE, I_CIM, I_SD, I_SWOUT, I_PWQ, I_PKEYS, I_PU, I_PV };

__device__ __forceinline__ int threadIdx_x_raw() { return (int)__builtin_amdgcn_workitem_id_x(); }
__device__ __forceinline__ uint32_t pack_bf16(float a, float b) {
  bf2 v; v[0] = (__bf16)a; v[1] = (__bf16)b; return __builtin_bit_cast(uint32_t, v);
}
__device__ __forceinline__ float bf_lo(uint32_t w) { return __uint_as_float(w << 16); }
__device__ __forceinline__ float bf_hi(uint32_t w) { return __uint_as_float(w & 0xffff0000u); }
__device__ __forceinline__ float fast_rcp(float x) { return __builtin_amdgcn_rcpf(x); }
__device__ __forceinline__ float gelu_tanh(float x) {
  float u = 0.7978845608028654f * (x + 0.044715f * x * x * x);
  float e = __expf(-2.0f * u);
  return x * fast_rcp(1.0f + e);
}
__device__ __forceinline__ float sigmoidf_(float x) { return fast_rcp(1.0f + __expf(-x)); }
__device__ __forceinline__ float siluf_(float x) { return x / (1.0f + expf(-x)); }
__device__ __forceinline__ uint32_t ord_key(float f) {
  uint32_t b = __float_as_uint(f);
  return b ^ ((b >> 31) ? 0xffffffffu : 0x80000000u);
}
__device__ __forceinline__ float ord_dec(uint32_t o) {
  uint32_t b = (o & 0x80000000u) ? (o ^ 0x80000000u) : ~o;
  return __uint_as_float(b);
}
__device__ __forceinline__ float wave_sum(float v) {
#pragma unroll
  for (int o = 32; o > 0; o >>= 1) v += __shfl_xor(v, o);
  return v;
}
__device__ __forceinline__ float* xrow_ptr(const Params& p, int row) {
  return row < TL ? p.out + (size_t)row * DM : (float*)(p.ws + OFF_HC) + (size_t)(row - TL) * DM;
}
__device__ __forceinline__ int row_batch(int row) { return row < TL ? (row >> 13) : 8; }

__device__ __forceinline__ int tid_() { int t = threadIdx_x_raw(); asm volatile("" : "+v"(t)); return t; }
struct __attribute__((aligned(16))) Smem {
  uint4 a[2][1024];
  uint4 b[2][1024];
};
__device__ __forceinline__ int lds_idx(int row, int ch) { return row * 8 + (ch ^ ((row >> 1) & 7)); }

__device__ __forceinline__ void compute_ktile(int tid__, const Smem& sm, int buf, f32x16 (&acc)[2][2]) {
  const int lane = tid__ & 63, w = tid__ >> 6, wr = w >> 1, wc = w & 1;
  const int swz = ((lane & 31) >> 1) & 7;
#pragma unroll
  for (int ks = 0; ks < 4; ++ks) {
    const int ch = (ks * 2 + (lane >> 5)) ^ swz;
    bf16x8 af[2], bfr[2];
#pragma unroll
    for (int mi = 0; mi < 2; ++mi) {
      uint4 v = sm.a[buf][(wr * 64 + mi * 32 + (lane & 31)) * 8 + ch];
      af[mi] = *(bf16x8*)&v;
    }
#pragma unroll
    for (int ni = 0; ni < 2; ++ni) {
      uint4 v = sm.b[buf][(wc * 64 + ni * 32 + (lane & 31)) * 8 + ch];
      bfr[ni] = *(bf16x8*)&v;
    }
#pragma unroll
    for (int mi = 0; mi < 2; ++mi)
#pragma unroll
      for (int ni = 0; ni < 2; ++ni)
        acc[mi][ni] = __builtin_amdgcn_mfma_f32_32x32x16_bf16(bfr[ni], af[mi], acc[mi][ni], 0, 0, 0);
  }
}

struct Stage8 { uint4 a0, a1, a2, a3, b0, b1, b2, b3; };
__device__ __forceinline__ Stage8 g_load(const bf16_t* ga, const bf16_t* gb, int lda, int ldb, int kt) {
  Stage8 s;
  s.a0 = *(const uint4*)(ga + kt * 64);
  s.a1 = *(const uint4*)(ga + (size_t)32 * lda + kt * 64);
  s.a2 = *(const uint4*)(ga + (size_t)64 * lda + kt * 64);
  s.a3 = *(const uint4*)(ga + (size_t)96 * lda + kt * 64);
  s.b0 = *(const uint4*)(gb + kt * 64);
  s.b1 = *(const uint4*)(gb + (size_t)32 * ldb + kt * 64);
  s.b2 = *(const uint4*)(gb + (size_t)64 * ldb + kt * 64);
  s.b3 = *(const uint4*)(gb + (size_t)96 * ldb + kt * 64);
  return s;
}
__device__ __forceinline__ void g_store(const Stage8& s, Smem& sm, int buf, int sidx) {
  sm.a[buf][sidx] = s.a0; sm.a[buf][sidx + 256] = s.a1; sm.a[buf][sidx + 512] = s.a2; sm.a[buf][sidx + 768] = s.a3;
  sm.b[buf][sidx] = s.b0; sm.b[buf][sidx + 256] = s.b1; sm.b[buf][sidx + 512] = s.b2; sm.b[buf][sidx + 768] = s.b3;
}
__device__ __forceinline__ void gemm_tile(int tid__, const bf16_t* __restrict__ A, int lda, const bf16_t* __restrict__ Bt, int ldb,
                                          int nk, Smem& sm, f32x16 (&acc)[2][2]) {
  const int t = tid__, lr = t >> 3, lc = t & 7;
  const bf16_t* ga = A + (size_t)lr * lda + lc * 8;
  const bf16_t* gb = Bt + (size_t)lr * ldb + lc * 8;
  const int sidx = lds_idx(lr, lc);
  Stage8 r0 = g_load(ga, gb, lda, ldb, 0);
  Stage8 r1 = g_load(ga, gb, lda, ldb, 1);
  g_store(r0, sm, 0, sidx);
  __syncthreads();
  for (int kt = 0; kt < nk - 2; kt += 2) {
    r0 = g_load(ga, gb, lda, ldb, kt + 2);
    compute_ktile(tid__, sm, 0, acc);
    g_store(r1, sm, 1, sidx);
    __syncthreads();
    r1 = g_load(ga, gb, lda, ldb, kt + 3);
    compute_ktile(tid__, sm, 1, acc);
    g_store(r0, sm, 0, sidx);
    __syncthreads();
  }
  compute_ktile(tid__, sm, 0, acc);
  g_store(r1, sm, 1, sidx);
  __syncthreads();
  compute_ktile(tid__, sm, 1, acc);
  __syncthreads();
}

template <class Epi>
__device__ __forceinline__ void gemm_phase(int tid__, const bf16_t* A, const bf16_t* Bt, int Mtiles, int NT, Smem& sm, Epi epi) {
  const int ntiles = Mtiles * NT;
  const int perm = (blockIdx.x & 7) * (gridDim.x >> 3) + (blockIdx.x >> 3);
  for (int base = 0; base < ntiles; base += gridDim.x) {
    const int v = base + perm;
    if (v >= ntiles) continue;
    int mt, nt;
    if (NT == 16) {
      const int half_tiles = Mtiles * 8, hf = v >= half_tiles ? 1 : 0, vv = v - hf * half_tiles;
      mt = vv >> 3; nt = hf * 8 + (vv & 7);
    } else { mt = v / NT; nt = v - mt * NT; }
    f32x16 acc[2][2];
#pragma unroll
    for (int mi = 0; mi < 2; ++mi)
#pragma unroll
      for (int ni = 0; ni < 2; ++ni)
#pragma unroll
        for (int r = 0; r < 16; ++r) acc[mi][ni][r] = 0.f;
    gemm_tile(tid__, A + (size_t)mt * 128 * DM, DM, Bt + (size_t)nt * 128 * DM, DM, 16, sm, acc);
    epi(acc, mt, nt);
    __syncthreads();
  }
}

__device__ __forceinline__ void cex_desc(uint32_t& a, uint32_t& b) { uint32_t mx = max(a, b), mn = min(a, b); a = mx; b = mn; }
__device__ __forceinline__ void sort16_desc(uint32_t (&v)[16]) {
#pragma unroll
  for (int k = 2; k <= 16; k <<= 1) {
#pragma unroll
    for (int j = k >> 1; j > 0; j >>= 1) {
#pragma unroll
      for (int i = 0; i < 16; ++i) {
        const int l = i ^ j;
        if (l > i) {
          if ((i & k) == 0) cex_desc(v[i], v[l]); else cex_desc(v[l], v[i]);
        }
      }
    }
  }
}
__device__ __forceinline__ void merge16_desc(uint32_t (&v)[16]) {
#pragma unroll
  for (int j = 8; j > 0; j >>= 1) {
#pragma unroll
    for (int i = 0; i < 16; ++i) {
      const int l = i ^ j;
      if (l > i) cex_desc(v[i], v[l]);
    }
  }
}

__device__ __forceinline__ void phase_setup(const Params& p, Smem& sm) {
  const int tid__ = tid_();
  const int tid = tid__, gtid = blockIdx.x * 256 + tid, gsz = gridDim.x * 256;
  {
    const size_t n16 = (size_t)4 * 16384 * 1024 / 16;
    for (int which = 0; which < 2; ++which) {
      const float4* src = (const float4*)p.in[which ? I_PV : I_PU];
      uint4* dst = (uint4*)(p.ws + (which ? OFF_PV : OFF_PU));
      const float sc = which ? 8.0f : 32.0f;
      for (size_t i = gtid; i < n16; i += gsz) {
        uint32_t o[4];
#pragma unroll
        for (int j = 0; j < 4; ++j) {
          const float4 a = src[4 * i + j];
          int w = 0;
          w = __builtin_amdgcn_cvt_pk_fp8_f32(a.x * sc, a.y * sc, w, false);
          w = __builtin_amdgcn_cvt_pk_fp8_f32(a.z * sc, a.w * sc, w, true);
          o[j] = (uint32_t)w;
        }
        const size_t e = i >> 6;
        const int piece = (int)(i & 63), slab = piece >> 3, sub = piece & 7;
        const size_t layer = e >> 14, ex = e & 16383;
        dst[((layer * 8 + slab) * 16384 + ex) * 8 + sub] = make_uint4(o[0], o[1], o[2], o[3]);
      }
    }
  }
  {
    for (int seg = 0; seg < 4; ++seg) {
      const int N = (seg == 0 || seg == 3) ? 2048 : 1024;
      const float* W = p.in[seg == 0 ? I_CMWIN : seg == 1 ? I_CMWOUT : seg == 2 ? I_SWIN : I_SWOUT];
      bf16_t* O = (bf16_t*)(p.ws + (seg == 0 ? OFF_WINC : seg == 1 ? OFF_WOUTC : seg == 2 ? OFF_WINS : OFF_WOUTS));
      const int total = 2 * N * 128;
      for (int i = gtid; i < total; i += gsz) {
        const int n = i % N, k8 = (i / N) % 128, m = i / (N * 128);
        int srcn = n;
        if (seg == 3) { const int tt = n >> 6, c = n & 63; srcn = c < 32 ? tt * 32 + c : 1024 + tt * 32 + (c - 32); }
        const float* s = W + (size_t)m * 1024 * N + (size_t)k8 * 8 * N + srcn;
        float f[8];
#pragma unroll
        for (int j = 0; j < 8; ++j) f[j] = s[(size_t)j * N];
        uint4 o; o.x = pack_bf16(f[0], f[1]); o.y = pack_bf16(f[2], f[3]); o.z = pack_bf16(f[4], f[5]); o.w = pack_bf16(f[6], f[7]);
        *(uint4*)(O + (size_t)m * N * 1024 + (size_t)n * 1024 + k8 * 8) = o;
      }
    }
    {
      const float4* src = (const float4*)p.in[I_CMWS];
      uint4* dst = (uint4*)(p.ws + OFF_WS);
      const int n8 = 2 * 8 * 128 * 128 / 8;
      for (int i = gtid; i < n8; i += gsz) {
        float4 a = src[2 * i], b = src[2 * i + 1];
        uint4 o; o.x = pack_bf16(a.x, a.y); o.y = pack_bf16(a.z, a.w); o.z = pack_bf16(b.x, b.y); o.w = pack_bf16(b.z, b.w);
        dst[i] = o;
      }
    }
  }
  {
    float* pe = (float*)(p.ws + OFF_PE);
    for (int i = gtid; i < 192 * 512; i += gsz) {
      const int pr = i >> 9, dd = i & 511, j = dd & 255;
      const float pos = (float)(pr < 128 ? pr : pr - 128);
      const float omega = 1.0f / powf(10000.0f, (float)j / 256.0f);
      const float ang = pos * omega;
      pe[i] = dd < 256 ? sinf(ang) : cosf(ang);
    }
  }
  {
    const int lane = tid & 63, gw = blockIdx.x * 4 + (tid >> 6), nw = gridDim.x * 4;
    bf16_t* weff = (bf16_t*)(p.ws + OFF_WEFF);
    for (int wt = gw; wt < 8192; wt += nw) {
      const int l = wt >> 11, rem = wt & 2047, hk = rem >> 7, mb = (rem >> 5) & 3, db = rem & 31;
      const float* ap = p.in[I_PWQ] + (size_t)l * 1024 * 4096 + (size_t)(db * 32 + (lane & 31)) * 4096 + hk * 256 + (lane >> 5) * 128;
      const float* bp = p.in[I_PKEYS] + ((size_t)(l * 16 + hk) * 128 + mb * 32 + (lane & 31)) * 256 + (lane >> 5) * 128;
      f32x16 acc;
#pragma unroll
      for (int r = 0; r < 16; ++r) acc[r] = 0.f;
      for (int s = 0; s < 128; s += 4) {
        const float4 av = *(const float4*)(ap + s), bv = *(const float4*)(bp + s);
        acc = __builtin_amdgcn_mfma_f32_32x32x2f32(av.x, bv.x, acc, 0, 0, 0);
        acc = __builtin_amdgcn_mfma_f32_32x32x2f32(av.y, bv.y, acc, 0, 0, 0);
        acc = __builtin_amdgcn_mfma_f32_32x32x2f32(av.z, bv.z, acc, 0, 0, 0);
        acc = __builtin_amdgcn_mfma_f32_32x32x2f32(av.w, bv.w, acc, 0, 0, 0);
      }
      bf16_t* o = weff + ((size_t)l * 2048 + hk * 128 + mb * 32 + (lane & 31)) * 1024 + db * 32 + 4 * (lane >> 5);
#pragma unroll
      for (int g = 0; g < 4; ++g) {
        uint2 v; v.x = pack_bf16(acc[4 * g], acc[4 * g + 1]); v.y = pack_bf16(acc[4 * g + 2], acc[4 * g + 3]);
        *(uint2*)(o + 8 * g) = v;
      }
    }
  }
  {
    float* sbuf = (float*)&sm;
    float* modp = (float*)(p.ws + OFF_MODP);
    for (int it = blockIdx.x; it < 4 * 24 * 8; it += gridDim.x) {
      const int l = it / 192, nb = (it / 8) % 24, sl = it & 7;
      __syncthreads();
      for (int i = tid; i < 9 * 128; i += 256) {
        const int r = i >> 7, d = sl * 128 + (i & 127);
        const float cv = r < 8 ? p.in[I_C][r * 1024 + d] : p.in[I_CCTX][d];
        sbuf[i] = siluf_(cv);
      }
      __syncthreads();
      const int n = nb * 256 + tid;
      const float* w = p.in[I_ADAW] + (size_t)l * 1024 * 6144 + (size_t)sl * 128 * 6144 + n;
      float acc[9];
#pragma unroll
      for (int r = 0; r < 9; ++r) acc[r] = 0.f;
      for (int d = 0; d < 128; ++d) {
        const float wv = w[(size_t)d * 6144];
#pragma unroll
        for (int r = 0; r < 9; ++r) acc[r] += sbuf[r * 128 + d] * wv;
      }
#pragma unroll
      for (int r = 0; r < 9; ++r) modp[((size_t)(l * 8 + sl) * 9 + r) * 6144 + n] = acc[r];
    }
    __syncthreads();
  }
}

__device__ __forceinline__ void phase_modfin(const Params& p) {
  const int tid__ = tid_();
  const int gtid = blockIdx.x * 256 + tid__, gsz = gridDim.x * 256;
  const float* modp = (const float*)(p.ws + OFF_MODP);
  float* mod = (float*)(p.ws + OFF_MOD);
  for (int i = gtid; i < 4 * 9 * 6144; i += gsz) {
    const int n = i % 6144, r = (i / 6144) % 9, l = i / (9 * 6144);
    float s = p.in[I_ADAB][l * 6144 + n];
#pragma unroll
    for (int sl = 0; sl < 8; ++sl) s += modp[((size_t)(l * 8 + sl) * 9 + r) * 6144 + n];
    mod[i] = s;
  }
}

__device__ __forceinline__ void load_row16(const float* src, int lane, float (&v)[16]) {
  const float4* s = (const float4*)src + lane * 4;
  float4 a = s[0], b = s[1], c = s[2], d = s[3];
  v[0] = a.x; v[1] = a.y; v[2] = a.z; v[3] = a.w; v[4] = b.x; v[5] = b.y; v[6] = b.z; v[7] = b.w;
  v[8] = c.x; v[9] = c.y; v[10] = c.z; v[11] = c.w; v[12] = d.x; v[13] = d.y; v[14] = d.z; v[15] = d.w;
}
__device__ __forceinline__ void store_row16(float* dst, int lane, const float (&v)[16]) {
  float4* s = (float4*)dst + lane * 4;
  s[0] = make_float4(v[0], v[1], v[2], v[3]); s[1] = make_float4(v[4], v[5], v[6], v[7]);
  s[2] = make_float4(v[8], v[9], v[10], v[11]); s[3] = make_float4(v[12], v[13], v[14], v[15]);
}
__device__ __forceinline__ void norm_mod_store(const float (&x)[16], const float* g, const float* sh, const float* sc, bf16_t* dst, int lane,
                                               uint8_t* dst8 = nullptr) {
  float ss = 0.f;
#pragma unroll
  for (int i = 0; i < 16; ++i) ss += x[i] * x[i];
  ss = wave_sum(ss);
  const float rstd = rsqrtf(ss * (1.0f / 1024.0f) + 1e-6f);
  float gv[16], sv[16], cv[16];
  load_row16(g, lane, gv); load_row16(sh, lane, sv); load_row16(sc, lane, cv);
  float y[16];
#pragma unroll
  for (int i = 0; i < 16; ++i) y[i] = x[i] * rstd * gv[i] * (1.0f + cv[i]) + sv[i];
  uint4 o0, o1;
  o0.x = pack_bf16(y[0], y[1]); o0.y = pack_bf16(y[2], y[3]); o0.z = pack_bf16(y[4], y[5]); o0.w = pack_bf16(y[6], y[7]);
  o1.x = pack_bf16(y[8], y[9]); o1.y = pack_bf16(y[10], y[11]); o1.z = pack_bf16(y[12], y[13]); o1.w = pack_bf16(y[14], y[15]);
  ((uint4*)dst)[2 * lane] = o0; ((uint4*)dst)[2 * lane + 1] = o1;
  if (dst8) {
    uint32_t w[4];
#pragma unroll
    for (int j = 0; j < 4; ++j) {
      int t = 0;
      t = __builtin_amdgcn_cvt_pk_fp8_f32(y[4 * j], y[4 * j + 1], t, false);
      t = __builtin_amdgcn_cvt_pk_fp8_f32(y[4 * j + 2], y[4 * j + 3], t, true);
      w[j] = (uint32_t)t;
    }
    ((uint4*)dst8)[lane] = make_uint4(w[0], w[1], w[2], w[3]);
  }
}


__device__ __forceinline__ void row_norm_pass(const Params& p, int tid__, int M, const float* g, const float* modl, int off_sh, int off_sc) {
  const int lane = tid__ & 63, gw = blockIdx.x * 4 + (tid__ >> 6), nw = gridDim.x * 4;
  bf16_t* xn = (bf16_t*)(p.ws + OFF_XN);
  if (gw >= M) return;
  float gv[16], w1[16], sh[16];
  load_row16(g, lane, gv);
  int cb = -1;
  float xnext[16];
  load_row16(xrow_ptr(p, gw), lane, xnext);
  uint4 po0 = make_uint4(0u, 0u, 0u, 0u), po1 = po0;
  int prow = gw;
  for (int row = gw; row < M; row += nw) {
    float x[16];
#pragma unroll
    for (int i = 0; i < 16; ++i) x[i] = xnext[i];
    float ss = 0.f;
#pragma unroll
    for (int i = 0; i < 16; ++i) ss += x[i] * x[i];
    __builtin_amdgcn_sched_barrier(0);
    {
      uint4* d = (uint4*)(xn + (size_t)prow * DM);
      d[2 * lane] = po0; d[2 * lane + 1] = po1;
      load_row16(xrow_ptr(p, row + nw < M ? row + nw : row), lane, xnext);
    }
    __builtin_amdgcn_sched_barrier(0);
    const int b = row_batch(row);
    if (b != cb) {
      cb = b;
      float cv[16];
      load_row16(modl + (size_t)b * 6144 + off_sc, lane, cv);
      load_row16(modl + (size_t)b * 6144 + off_sh, lane, sh);
#pragma unroll
      for (int i = 0; i < 16; ++i) w1[i] = gv[i] * (1.0f + cv[i]);
    }
    ss = wave_sum(ss);
    const float rstd = rsqrtf(ss * (1.0f / 1024.0f) + 1e-6f);
    float y[16];
#pragma unroll
    for (int i = 0; i < 16; ++i) y[i] = x[i] * rstd * w1[i] + sh[i];
    po0.x = pack_bf16(y[0], y[1]); po0.y = pack_bf16(y[2], y[3]); po0.z = pack_bf16(y[4], y[5]); po0.w = pack_bf16(y[6], y[7]);
    po1.x = pack_bf16(y[8], y[9]); po1.y = pack_bf16(y[10], y[11]); po1.z = pack_bf16(y[12], y[13]); po1.w = pack_bf16(y[14], y[15]);
    prow = row;
  }
  uint4* d = (uint4*)(xn + (size_t)prow * DM);
  d[2 * lane] = po0; d[2 * lane + 1] = po1;
}
__device__ __forceinline__ void phase_first_norm(const Params& p) {
  const int tid__ = tid_();
  const int lane = tid__ & 63, gw = blockIdx.x * 4 + (tid__ >> 6), nw = gridDim.x * 4;
  const float* pe = (const float*)(p.ws + OFF_PE);
  const float* mod = (const float*)(p.ws + OFF_MOD);
  bf16_t* xn = (bf16_t*)(p.ws + OFF_XN);
  for (int row = gw; row < TT; row += nw) {
    float x[16];
    if (row < TL) {
      load_row16(p.in[I_X] + (size_t)row * DM, lane, x);
      const int tkn = row & 8191, gr = tkn >> 6, gc = tkn & 63;
      const float* pp = lane < 32 ? pe + gr * 512 + 16 * lane : pe + (128 + gc) * 512 + 16 * lane - 512;
      float pv[16];
      load_row16(pp - 16 * lane, lane, pv);
#pragma unroll
      for (int i = 0; i < 16; ++i) x[i] += pv[i];
    } else {
      load_row16(p.in[I_CTX] + (size_t)(row - TL) * DM, lane, x);
    }
    store_row16(xrow_ptr(p, row), lane, x);
    const float* m = mod + (size_t)(0 * 9 + row_batch(row)) * 6144;
    norm_mod_store(x, p.in[I_N1G], m, m + 1024, xn + (size_t)row * DM, lane);
  }
}

__device__ __forceinline__ void phase_norm2(const Params& p, int l, int M) {
  const int tid__ = tid_();
  row_norm_pass(p, tid__, M, p.in[I_N2G] + l * 1024, (const float*)(p.ws + OFF_MOD) + (size_t)l * 9 * 6144, 3072, 4096);
}

__device__ __forceinline__ void phase_cm_in(const Params& p, int k, Smem& sm) {
  const int tid__ = tid_();
  bf16_t* Z = (bf16_t*)(p.ws + OFF_BUF1);
  float* part = (float*)(p.ws + OFF_PART);
  const int lane = tid__ & 63, w = tid__ >> 6, wr = w >> 1, wc = w & 1;
  gemm_phase(tid__, (const bf16_t*)(p.ws + OFF_XN), (const bf16_t*)(p.ws + OFF_WINC) + (size_t)k * 2048 * 1024, TT / 128, 16, sm,
    [&](f32x16 (&acc)[2][2], int mt, int nt) {
#pragma unroll
      for (int mi = 0; mi < 2; ++mi) {
        const int row = mt * 128 + wr * 64 + mi * 32 + (lane & 31);
        float s = 0.f, s2 = 0.f;
#pragma unroll
        for (int ni = 0; ni < 2; ++ni) {
          const int col = nt * 128 + wc * 64 + ni * 32 + 4 * (lane >> 5);
#pragma unroll
          for (int g = 0; g < 4; ++g) {
            float v0 = gelu_tanh(acc[mi][ni][4 * g]), v1 = gelu_tanh(acc[mi][ni][4 * g + 1]);
            float v2 = gelu_tanh(acc[mi][ni][4 * g + 2]), v3 = gelu_tanh(acc[mi][ni][4 * g + 3]);
            s += (v0 + v1) + (v2 + v3);
            s2 += (v0 * v0 + v1 * v1) + (v2 * v2 + v3 * v3);
            uint2 o; o.x = pack_bf16(v0, v1); o.y = pack_bf16(v2, v3);
            *(uint2*)(Z + (size_t)row * 2048 + col + 8 * g) = o;
          }
        }
        if (nt >= 8) {
          s += __shfl_xor(s, 32); s2 += __shfl_xor(s2, 32);
          if (lane < 32) *(float2*)(part + (size_t)row * 32 + ((nt - 8) * 2 + wc) * 2) = make_float2(s, s2);
        }
      }
    });
}

constexpr int STG_ROWB = 272;
__device__ __forceinline__ void phase_cm_gate(const Params& p, int k, Smem& sm) {
  const int tid__ = tid_();
  __shared__ float stat[128][2];
  const bf16_t* Z = (const bf16_t*)(p.ws + OFF_BUF1);
  bf16_t* UV = (bf16_t*)(p.ws + OFF_BUF2);
  const float* part = (const float*)(p.ws + OFF_PART);
  const bf16_t* WSb = (const bf16_t*)(p.ws + OFF_WS) + (size_t)k * 8 * 128 * 128;
  const float* lng = p.in[I_CMLNG] + k * 1024;
  const float* lnb = p.in[I_CMLNB] + k * 1024;
  const float* bs = p.in[I_CMBS] + k * 8 * 128;
  const int t = tid__, lane = t & 63, w = t >> 6, wr = w >> 1, wc = w & 1;
  const int ntiles = (TT / 128) * 8;
  for (int tile = blockIdx.x; tile < ntiles; tile += gridDim.x) {
    const int c = tile >> 3, h = tile & 7;
    if (t < 128) {
      const float4* pp = (const float4*)(part + (size_t)(c * 128 + t) * 32);
      float s = 0.f, s2 = 0.f;
#pragma unroll
      for (int i = 0; i < 8; ++i) { float4 v = pp[i]; s += v.x + v.z; s2 += v.y + v.w; }
      const float mu = s * (1.0f / 1024.0f);
      const float var = fmaxf(s2 * (1.0f / 1024.0f) - mu * mu, 0.f);
      stat[t][0] = mu; stat[t][1] = rsqrtf(var + 1e-6f);
    }
    {
      const int lr = t >> 3, lc = t & 7;
      const bf16_t* ga = WSb + (size_t)h * 128 * 128 + (size_t)lr * 128 + lc * 8;
#pragma unroll
      for (int kt = 0; kt < 2; ++kt)
#pragma unroll
        for (int i = 0; i < 4; ++i)
          sm.a[kt][lds_idx(lr + 32 * i, lc)] = *(const uint4*)(ga + (size_t)i * 32 * 128 + kt * 64);
    }
    {
      const int c16 = t & 15, d0 = c16 * 8;
      uint4 raw[8];
#pragma unroll
      for (int i = 0; i < 8; ++i) raw[i] = *(const uint4*)(Z + (size_t)(c * 128 + (t >> 4) + 16 * i) * 2048 + 1024 + h * 128 + d0);
      const float4 g0 = *(const float4*)(lng + h * 128 + d0), g1 = *(const float4*)(lng + h * 128 + d0 + 4);
      const float4 b0 = *(const float4*)(lnb + h * 128 + d0), b1 = *(const float4*)(lnb + h * 128 + d0 + 4);
      const float gg[8] = {g0.x, g0.y, g0.z, g0.w, g1.x, g1.y, g1.z, g1.w};
      const float bb[8] = {b0.x, b0.y, b0.z, b0.w, b1.x, b1.y, b1.z, b1.w};
      __syncthreads();
#pragma unroll
      for (int i = 0; i < 8; ++i) {
        const int q = (t >> 4) + 16 * i, kq = q & 63;
        const float mu = stat[q][0], rstd = stat[q][1];
        bf16_t* bl = (bf16_t*)&sm.b[q >> 6][0];
        const uint32_t wv[4] = {raw[i].x, raw[i].y, raw[i].z, raw[i].w};
#pragma unroll
        for (int e = 0; e < 8; ++e) {
          const float v = (e & 1) ? bf_hi(wv[e >> 1]) : bf_lo(wv[e >> 1]);
          const float y = (v - mu) * rstd * gg[e] + bb[e];
          bl[(size_t)lds_idx(d0 + e, kq >> 3) * 8 + (kq & 7)] = (bf16_t)(pack_bf16(y, y) & 0xffff);
        }
      }
    }
    __syncthreads();
    f32x16 acc[2][2];
#pragma unroll
    for (int mi = 0; mi < 2; ++mi)
#pragma unroll
      for (int ni = 0; ni < 2; ++ni)
#pragma unroll
        for (int r = 0; r < 16; ++r) acc[mi][ni][r] = 0.f;
    compute_ktile(tid__, sm, 0, acc);
    compute_ktile(tid__, sm, 1, acc);
    __syncthreads();
    {
      unsigned char* l = (unsigned char*)&sm;
#pragma unroll
      for (int mi = 0; mi < 2; ++mi) {
        const int pl = wr * 64 + mi * 32 + (lane & 31);
        const float bsv = bs[h * 128 + pl];
#pragma unroll
        for (int ni = 0; ni < 2; ++ni) {
          const int col = wc * 64 + ni * 32 + 4 * (lane >> 5);
#pragma unroll
          for (int g = 0; g < 4; ++g) {
            uint2 o; o.x = pack_bf16(acc[mi][ni][4 * g] + bsv, acc[mi][ni][4 * g + 1] + bsv);
            o.y = pack_bf16(acc[mi][ni][4 * g + 2] + bsv, acc[mi][ni][4 * g + 3] + bsv);
            *(uint2*)(l + pl * STG_ROWB + (col + 8 * g) * 2) = o;
          }
        }
      }
      __syncthreads();
#pragma unroll
      for (int i = 0; i < 8; ++i) {
        const int r = (t >> 4) + 16 * i, c8 = t & 15;
        const size_t row = (size_t)c * 128 + r;
        const uint4 gv = *(const uint4*)(l + r * STG_ROWB + c8 * 16);
        const uint4 uu = *(const uint4*)(Z + row * 2048 + h * 128 + c8 * 8);
        const uint32_t a[4] = {gv.x, gv.y, gv.z, gv.w}, b[4] = {uu.x, uu.y, uu.z, uu.w};
        uint32_t o[4];
#pragma unroll
        for (int j = 0; j < 4; ++j) o[j] = pack_bf16(bf_lo(a[j]) * bf_lo(b[j]), bf_hi(a[j]) * bf_hi(b[j]));
        *(uint4*)(UV + row * 1024 + h * 128 + c8 * 8) = make_uint4(o[0], o[1], o[2], o[3]);
      }
    }
    __syncthreads();
  }
}

__device__ __forceinline__ void phase_cm_out(const Params& p, int l, int k, Smem& sm) {
  const int tid__ = tid_();
  const float* mod = (const float*)(p.ws + OFF_MOD);
  const int lane = tid__ & 63, w = tid__ >> 6, wr = w >> 1, wc = w & 1;
  gemm_phase(tid__, (const bf16_t*)(p.ws + OFF_BUF2), (const bf16_t*)(p.ws + OFF_WOUTC) + (size_t)k * 1024 * 1024, TT / 128, 8, sm,
    [&](f32x16 (&acc)[2][2], int mt, int nt) {
      const float* g1 = mod + (size_t)(l * 9 + row_batch(mt * 128)) * 6144 + 2048;
#pragma unroll
      for (int mi = 0; mi < 2; ++mi) {
        const int row = mt * 128 + wr * 64 + mi * 32 + (lane & 31);
        float* xr = xrow_ptr(p, row);
#pragma unroll
        for (int ni = 0; ni < 2; ++ni) {
          const int col = nt * 128 + wc * 64 + ni * 32 + 4 * (lane >> 5);
#pragma unroll
          for (int g = 0; g < 4; ++g) {
            float4 xv = *(float4*)(xr + col + 8 * g);
            const float4 gv = *(const float4*)(g1 + col + 8 * g);
            xv.x += gv.x * acc[mi][ni][4 * g]; xv.y += gv.y * acc[mi][ni][4 * g + 1];
            xv.z += gv.z * acc[mi][ni][4 * g + 2]; xv.w += gv.w * acc[mi][ni][4 * g + 3];
            *(float4*)(xr + col + 8 * g) = xv;
          }
        }
      }
    });
}

__device__ __forceinline__ void phase_ssm_in(const Params& p, int k, Smem& sm) {
  const int tid__ = tid_();
  bf16_t* U = (bf16_t*)(p.ws + OFF_BUF2);
  const int lane = tid__ & 63, w = tid__ >> 6, wr = w >> 1, wc = w & 1;
  gemm_phase(tid__, (const bf16_t*)(p.ws + OFF_XN), (const bf16_t*)(p.ws + OFF_WINS) + (size_t)k * 1024 * 1024, TT / 128, 8, sm,
    [&](f32x16 (&acc)[2][2], int mt, int nt) {
#pragma unroll
      for (int mi = 0; mi < 2; ++mi) {
        const int row = mt * 128 + wr * 64 + mi * 32 + (lane & 31);
#pragma unroll
        for (int ni = 0; ni < 2; ++ni) {
          const int col = nt * 128 + wc * 64 + ni * 32 + 4 * (lane >> 5);
#pragma unroll
          for (int g = 0; g < 4; ++g) {
            const int cc = col + 8 * g, grp = cc >> 4, ch = cc & 15;
            uint2 o; o.x = pack_bf16(acc[mi][ni][4 * g], acc[mi][ni][4 * g + 1]); o.y = pack_bf16(acc[mi][ni][4 * g + 2], acc[mi][ni][4 * g + 3]);
            *(uint2*)(U + ((size_t)grp * TT + row) * 16 + ch) = o;
          }
        }
      }
    });
}

constexpr int SCAN_ROWB = 272;
constexpr int SCAN_WAVE_LDS = 32 * SCAN_ROWB;
__device__ __forceinline__ void scan_item(int tid__, const Params& p, int k, int item, unsigned char* lds) {
  const int lane = tid__ & 63;
  const int dir = item & 1, g = (item >> 1) & 63, b = item >> 7;
  const bf16_t* U = (const bf16_t*)(p.ws + OFF_BUF2) + (size_t)g * TT * 16;
  bf16_t* Y = (bf16_t*)(p.ws + OFF_BUF1) + (size_t)dir * TT * 1024 + (size_t)g * TT * 16;
  const int pbase = ((k * 2 + dir) * 64 + g) * 64;
  const float step = expf(p.in[I_LSTEP][(k * 2 + dir) * 64 + g]);
  float ar, ai;
  {
    const float lr = p.in[I_LRE][pbase + lane], li = p.in[I_LIM][pbase + lane];
    const float mag = expf(lr * step);
    ar = mag * cosf(li * step); ai = mag * sinf(li * step);
  }
  bf16x8 bfrag[4];
#pragma unroll
  for (int hb = 0; hb < 2; ++hb) {
    const int pp = hb * 32 + (lane & 31);
    const float lr = p.in[I_LRE][pbase + pp], li = p.in[I_LIM][pbase + pp];
    const float mag = expf(lr * step);
    const float a_r = mag * cosf(li * step), a_i = mag * sinf(li * step);
    const float den = lr * lr + li * li;
    const float cr = ((a_r - 1.0f) * lr + a_i * li) / den;
    const float ci = (a_i * lr - (a_r - 1.0f) * li) / den;
    const float* bre = p.in[I_BRE] + (size_t)(pbase + pp) * 16 + 8 * (lane >> 5);
    const float* bim = p.in[I_BIM] + (size_t)(pbase + pp) * 16 + 8 * (lane >> 5);
    float re[8], im[8];
#pragma unroll
    for (int j = 0; j < 8; ++j) { re[j] = cr * bre[j] - ci * bim[j]; im[j] = cr * bim[j] + ci * bre[j]; }
    uint4 vr, vi;
    vr.x = pack_bf16(re[0], re[1]); vr.y = pack_bf16(re[2], re[3]); vr.z = pack_bf16(re[4], re[5]); vr.w = pack_bf16(re[6], re[7]);
    vi.x = pack_bf16(im[0], im[1]); vi.y = pack_bf16(im[2], im[3]); vi.z = pack_bf16(im[4], im[5]); vi.w = pack_bf16(im[6], im[7]);
    bfrag[hb] = *(bf16x8*)&vr; bfrag[2 + hb] = *(bf16x8*)&vi;
  }
  bf16x8 cfrag[4];
  {
    const int cbase = (((k * 2 + dir) * 64 + g) * 16 + (lane & 15)) * 64;
#pragma unroll
    for (int ks = 0; ks < 4; ++ks) {
      const int p0 = 16 * ks + 4 * (lane >> 4);
      const float4 cr = *(const float4*)(p.in[I_CRE] + cbase + p0), ci = *(const float4*)(p.in[I_CIM] + cbase + p0);
      uint4 v; v.x = pack_bf16(cr.x, -ci.x); v.y = pack_bf16(cr.y, -ci.y); v.z = pack_bf16(cr.z, -ci.z); v.w = pack_bf16(cr.w, -ci.w);
      cfrag[ks] = *(bf16x8*)&v;
    }
  }
  float hr = 0.f, hi = 0.f;
  const int ctx0 = TL + b * 256, lat0 = b * 8192;
  auto chunk_r0 = [&](int ci) -> int {
    int base, len, cc;
    if (ci < 8) { base = ctx0; len = 256; cc = ci; } else { base = lat0; len = 8192; cc = ci - 8; }
    return dir == 0 ? base + cc * 32 : base + len - 32 * (cc + 1);
  };
  const int tau_l = lane & 31;
  uint4 unext;
  {
    const int r0 = chunk_r0(0);
    const int row = dir == 0 ? r0 + tau_l : r0 + 31 - tau_l;
    unext = *(const uint4*)(U + (size_t)row * 16 + 8 * (lane >> 5));
  }
  uint2 ypend[2] = {make_uint2(0u, 0u), make_uint2(0u, 0u)};
  size_t opend[2];
  {
    const int r0 = chunk_r0(0);
#pragma unroll
    for (int nb = 0; nb < 2; ++nb) {
      const int tau = nb * 16 + (lane & 15);
      opend[nb] = (size_t)(dir == 0 ? r0 + tau : r0 + 31 - tau) * 16 + 4 * (lane >> 4);
    }
  }
  for (int ci = 0; ci < 264; ++ci) {
    const int r0 = chunk_r0(ci);
    const uint4 ucur = unext;
    const bf16x8 afrag = *(const bf16x8*)&ucur;
    f32x16 bu[4];
#pragma unroll
    for (int nb = 0; nb < 4; ++nb) {
#pragma unroll
      for (int r = 0; r < 16; ++r) bu[nb][r] = 0.f;
      bu[nb] = __builtin_amdgcn_mfma_f32_32x32x16_bf16(afrag, bfrag[nb], bu[nb], 0, 0, 0);
    }
    __builtin_amdgcn_sched_barrier(0);
    {
      *(uint2*)(Y + opend[0]) = ypend[0];
      *(uint2*)(Y + opend[1]) = ypend[1];
      const int r1 = chunk_r0(ci + 1 < 264 ? ci + 1 : 263);
      const int row = dir == 0 ? r1 + tau_l : r1 + 31 - tau_l;
      unext = *(const uint4*)(U + (size_t)row * 16 + 8 * (lane >> 5));
    }
    __builtin_amdgcn_sched_barrier(0);
#pragma unroll
    for (int r = 0; r < 16; ++r) {
      auto s0 = __builtin_amdgcn_permlane32_swap(__float_as_uint(bu[0][r]), __float_as_uint(bu[1][r]), false, false);
      bu[0][r] = __uint_as_float(s0[0]); bu[1][r] = __uint_as_float(s0[1]);
      auto s1 = __builtin_amdgcn_permlane32_swap(__float_as_uint(bu[2][r]), __float_as_uint(bu[3][r]), false, false);
      bu[2][r] = __uint_as_float(s1[0]); bu[3][r] = __uint_as_float(s1[1]);
    }
    asm volatile("" ::: "memory");
#pragma unroll
    for (int tau = 0; tau < 32; ++tau) {
      const int hb = (tau >> 2) & 1, r = (tau & 3) + 4 * (tau >> 3);
      const float bre = hb ? bu[1][r] : bu[0][r], bim = hb ? bu[3][r] : bu[2][r];
      const float nr = fmaf(ar, hr, fmaf(-ai, hi, bre));
      const float ni = fmaf(ar, hi, fmaf(ai, hr, bim));
      hr = nr; hi = ni;
      *(uint32_t*)(lds + tau * SCAN_ROWB + lane * 4) = pack_bf16(hr, hi);
    }
    asm volatile("s_waitcnt lgkmcnt(0)" ::: "memory");
#pragma unroll
    for (int nb = 0; nb < 2; ++nb) {
      f32x4 y = {0.f, 0.f, 0.f, 0.f};
#pragma unroll
      for (int ks = 0; ks < 4; ++ks) {
        const uint4 hv = *(const uint4*)(lds + (nb * 16 + (lane & 15)) * SCAN_ROWB + ks * 64 + (lane >> 4) * 16);
        y = __builtin_amdgcn_mfma_f32_16x16x32_bf16(cfrag[ks], *(const bf16x8*)&hv, y, 0, 0, 0);
      }
      const int tau = nb * 16 + (lane & 15);
      const int row = dir == 0 ? r0 + tau : r0 + 31 - tau;
      ypend[nb].x = pack_bf16(y[0], y[1]); ypend[nb].y = pack_bf16(y[2], y[3]);
      opend[nb] = (size_t)row * 16 + 4 * (lane >> 4);
    }
    asm volatile("s_waitcnt lgkmcnt(0)" ::: "memory");
  }
  *(uint2*)(Y + opend[0]) = ypend[0];
  *(uint2*)(Y + opend[1]) = ypend[1];
}
__device__ __forceinline__ void phase_scan(const Params& p, int k, Smem& sm) {
  const int tid__ = tid_();
  const int w = tid__ >> 6;
  const int nact = gridDim.x < 256 ? gridDim.x : 256;
  const int ipb = (1024 + nact - 1) / nact;
  unsigned char* lds = (unsigned char*)&sm + (size_t)w * SCAN_WAVE_LDS;
  if ((int)blockIdx.x < nact) {
    for (int s = w; s < ipb; s += 4) {
      const int item = blockIdx.x * ipb + s;
      if (item < 1024) scan_item(tid__, p, k, item, lds);
    }
  }
}

__device__ __forceinline__ void phase_ssm_comb(const Params& p, int k) {
  const int tid__ = tid_();
  const bf16_t* U = (const bf16_t*)(p.ws + OFF_BUF2);
  const bf16_t* YF = (const bf16_t*)(p.ws + OFF_BUF1);
  const bf16_t* YB = YF + (size_t)TT * 1024;
  bf16_t* G = (bf16_t*)(p.ws + OFF_XN);
  const float* dsk = p.in[I_SD] + k * 1024;
  const int nblk = TT / 8;
  for (int rb = blockIdx.x; rb < nblk; rb += gridDim.x) {
#pragma unroll
    for (int it = 0; it < 4; ++it) {
      const int e = it * 256 + tid__;
      const int row = rb * 8 + (e >> 7), g = (e >> 1) & 63, half = e & 1;
      const size_t off = ((size_t)g * TT + row) * 16 + half * 8;
      const uint4 u = *(const uint4*)(U + off), yf = *(const uint4*)(YF + off), yb = *(const uint4*)(YB + off);
      const float4 d0 = *(const float4*)(dsk + g * 16 + half * 8), d1 = *(const float4*)(dsk + g * 16 + half * 8 + 4);
      const uint32_t uw[4] = {u.x, u.y, u.z, u.w}, fw[4] = {yf.x, yf.y, yf.z, yf.w}, bw[4] = {yb.x, yb.y, yb.z, yb.w};
      const float dd[8] = {d0.x, d0.y, d0.z, d0.w, d1.x, d1.y, d1.z, d1.w};
      uint32_t ow[4];
#pragma unroll
      for (int i = 0; i < 4; ++i) {
        const float a = gelu_tanh(bf_lo(fw[i]) + bf_lo(bw[i]) + dd[2 * i] * bf_lo(uw[i]));
        const float c = gelu_tanh(bf_hi(fw[i]) + bf_hi(bw[i]) + dd[2 * i + 1] * bf_hi(uw[i]));
        ow[i] = pack_bf16(a, c);
      }
      *(uint4*)(G + (size_t)row * 1024 + g * 16 + half * 8) = make_uint4(ow[0], ow[1], ow[2], ow[3]);
    }
  }
}

__device__ __forceinline__ void phase_ssm_out(const Params& p, int l, int k, int M, Smem& sm) {
  const int tid__ = tid_();
  const float* mod = (const float*)(p.ws + OFF_MOD);
  const int lane = tid__ & 63, w = tid__ >> 6, wr = w >> 1, wc = w & 1;
  gemm_phase(tid__, (const bf16_t*)(p.ws + OFF_XN), (const bf16_t*)(p.ws + OFF_WOUTS) + (size_t)k * 2048 * 1024, M / 128, 16, sm,
    [&](f32x16 (&acc)[2][2], int mt, int nt) {
      const float* g1 = mod + (size_t)(l * 9 + row_batch(mt * 128)) * 6144 + 2048;
#pragma unroll
      for (int mi = 0; mi < 2; ++mi) {
        const int row = mt * 128 + wr * 64 + mi * 32 + (lane & 31);
        float* xr = xrow_ptr(p, row);
        const int col = (nt * 2 + wc) * 32 + 4 * (lane >> 5);
#pragma unroll
        for (int g = 0; g < 4; ++g) {
          float4 xv = *(float4*)(xr + col + 8 * g);
          const float4 gv = *(const float4*)(g1 + col + 8 * g);
          xv.x += gv.x * acc[mi][0][4 * g] * sigmoidf_(acc[mi][1][4 * g]);
          xv.y += gv.y * acc[mi][0][4 * g + 1] * sigmoidf_(acc[mi][1][4 * g + 1]);
          xv.z += gv.z * acc[mi][0][4 * g + 2] * sigmoidf_(acc[mi][1][4 * g + 2]);
          xv.w += gv.w * acc[mi][0][4 * g + 3] * sigmoidf_(acc[mi][1][4 * g + 3]);
          *(float4*)(xr + col + 8 * g) = xv;
        }
      }
    });
}

__device__ __forceinline__ void phase_peer_score(const Params& p, int l, int M, Smem& sm) {
  const int tid__ = tid_();
  uint32_t* topk = (uint32_t*)(p.ws + OFF_TOPK);
  const int lane = tid__ & 63, w = tid__ >> 6, wr = w >> 1, wc = w & 1;
  uint32_t* ks = (uint32_t*)&sm;
  gemm_phase(tid__, (const bf16_t*)(p.ws + OFF_XN), (const bf16_t*)(p.ws + OFF_WEFF) + (size_t)l * 2048 * 1024, M / 128, 16, sm,
    [&](f32x16 (&acc)[2][2], int mt, int nt) {
#pragma unroll
      for (int mi = 0; mi < 2; ++mi) {
        uint32_t va[16], vb[16];
#pragma unroll
        for (int r = 0; r < 16; ++r) {
          const int c0 = wc * 64 + 8 * (r >> 2) + 4 * (lane >> 5) + (r & 3);
          va[r] = (ord_key(acc[mi][0][r]) & ~0x7fu) | (uint32_t)(127 - c0);
          vb[r] = (ord_key(acc[mi][1][r]) & ~0x7fu) | (uint32_t)(127 - (c0 + 32));
        }
        sort16_desc(va); __builtin_amdgcn_sched_barrier(0); sort16_desc(vb); __builtin_amdgcn_sched_barrier(0);
        uint32_t m[16];
#pragma unroll
        for (int i = 0; i < 16; ++i) m[i] = max(va[i], vb[15 - i]);
        merge16_desc(m);
        uint32_t q[16];
#pragma unroll
        for (int i = 0; i < 16; ++i) q[i] = __shfl_xor(m[15 - i], 32);
#pragma unroll
        for (int i = 0; i < 16; ++i) m[i] = max(m[i], q[i]);
        merge16_desc(m);
        if (lane < 32) {
          uint4* dst = (uint4*)(ks + ((((wr * 2 + mi) * 2 + wc) * 32 + lane) * 16));
          dst[0] = make_uint4(m[0], m[1], m[2], m[3]); dst[1] = make_uint4(m[4], m[5], m[6], m[7]);
          dst[2] = make_uint4(m[8], m[9], m[10], m[11]); dst[3] = make_uint4(m[12], m[13], m[14], m[15]);
        }
        __builtin_amdgcn_sched_barrier(0);
      }
      __syncthreads();
      {
        const int mi = wc, rl = lane & 31;
        const uint4* la = (const uint4*)(ks + ((((wr * 2 + mi) * 2 + 0) * 32 + rl) * 16));
        const uint4* lb = (const uint4*)(ks + ((((wr * 2 + mi) * 2 + 1) * 32 + rl) * 16));
        uint32_t a[16], b[16];
#pragma unroll
        for (int i = 0; i < 4; ++i) {
          const uint4 x = la[i], y = lb[i];
          a[4 * i] = x.x; a[4 * i + 1] = x.y; a[4 * i + 2] = x.z; a[4 * i + 3] = x.w;
          b[4 * i] = y.x; b[4 * i + 1] = y.y; b[4 * i + 2] = y.z; b[4 * i + 3] = y.w;
        }
        uint32_t m[16];
#pragma unroll
        for (int i = 0; i < 16; ++i) m[i] = max(a[i], b[15 - i]);
        merge16_desc(m);
        if (lane < 32) {
          const int row = mt * 128 + wr * 64 + mi * 32 + rl;
          uint4* dst = (uint4*)(topk + (size_t)row * 256 + nt * 16);
          dst[0] = make_uint4(m[0], m[1], m[2], m[3]); dst[1] = make_uint4(m[4], m[5], m[6], m[7]);
          dst[2] = make_uint4(m[8], m[9], m[10], m[11]); dst[3] = make_uint4(m[12], m[13], m[14], m[15]);
        }
      }
    });
}

typedef float f32x2 __attribute__((ext_vector_type(2)));
typedef _Float16 f16x2 __attribute__((ext_vector_type(2)));
__device__ __forceinline__ void fp8x16_to_f32(const uint4& r, float (&f)[16]) {
  const uint32_t w[4] = {r.x, r.y, r.z, r.w};
#pragma unroll
  for (int j = 0; j < 4; ++j) {
    const f32x2 lo = __builtin_amdgcn_cvt_pk_f32_fp8((int)w[j], false), hi = __builtin_amdgcn_cvt_pk_f32_fp8((int)w[j], true);
    f[4 * j] = lo.x; f[4 * j + 1] = lo.y; f[4 * j + 2] = hi.x; f[4 * j + 3] = hi.y;
  }
}
__device__ __forceinline__ void peer_load4(const uint8_t* PU, const uint8_t* PV, uint32_t idsr, int bl, int lane, uint4 (&U)[4], uint4 (&V)[4]) {
#pragma unroll
  for (int e = 0; e < 4; ++e) {
    const uint32_t id = __builtin_amdgcn_readlane(idsr, bl + e);
    U[e] = ((const uint4*)(PU + (size_t)id * 1024))[lane];
    V[e] = ((const uint4*)(PV + (size_t)id * 1024))[lane];
  }
}
__device__ __forceinline__ void peer_comp4(const uint4 (&U)[4], const uint4 (&V)[4], const float (&hf)[16], float gwr, int bl, int lane, float (&acc)[16]) {
  float pd[4];
#pragma unroll
  for (int e = 0; e < 4; ++e) {
    float uf[16];
    fp8x16_to_f32(U[e], uf);
    float s0 = 0.f, s1 = 0.f;
#pragma unroll
    for (int i = 0; i < 8; ++i) { s0 = fmaf(hf[2 * i], uf[2 * i], s0); s1 = fmaf(hf[2 * i + 1], uf[2 * i + 1], s1); }
    pd[e] = s0 + s1;
  }
  float r2[2], r1;
#pragma unroll
  for (int j = 0; j < 2; ++j) {
    const float keep = (lane & 1) ? pd[2 * j + 1] : pd[2 * j], send = (lane & 1) ? pd[2 * j] : pd[2 * j + 1];
    r2[j] = keep + __shfl_xor(send, 1);
  }
  {
    const float keep = (lane & 2) ? r2[1] : r2[0], send = (lane & 2) ? r2[0] : r2[1];
    r1 = keep + __shfl_xor(send, 2);
  }
  r1 += __shfl_xor(r1, 4); r1 += __shfl_xor(r1, 8); r1 += __shfl_xor(r1, 16); r1 += __shfl_xor(r1, 32);
  const float wv = gelu_tanh(r1 * (1.0f / 32.0f)) * __shfl(gwr, bl + (lane & 3)) * (1.0f / 8.0f);
#pragma unroll
  for (int e = 0; e < 4; ++e) {
    const float we = __uint_as_float(__builtin_amdgcn_readlane(__float_as_uint(wv), e));
    float vf[16];
    fp8x16_to_f32(V[e], vf);
#pragma unroll
    for (int i = 0; i < 16; ++i) acc[i] = fmaf(we, vf[i], acc[i]);
  }
}
__device__ __forceinline__ void phase_peer_gather(const Params& p, int l, int M) {
  const int tid__ = tid_();
  const int lane = tid__ & 63, gw = blockIdx.x * 4 + (tid__ >> 6), nw = gridDim.x * 4;
  const uint32_t* topk = (const uint32_t*)(p.ws + OFF_TOPK);
  bf16_t* xn = (bf16_t*)(p.ws + OFF_XN);
  const uint8_t* PU = (const uint8_t*)(p.ws + OFF_PU) + (size_t)l * 16384 * 1024;
  const uint8_t* PV = (const uint8_t*)(p.ws + OFF_PV) + (size_t)l * 16384 * 1024;
  const float* mod = (const float*)(p.ws + OFF_MOD);
  int ic, jc; const bool valid = lane < 50;
  {
    const int c = lane;
    if (c < 16) { ic = 0; jc = c; } else if (c < 24) { ic = 1; jc = c - 16; } else if (c < 29) { ic = 2; jc = c - 24; }
    else if (c < 33) { ic = 3; jc = c - 29; } else if (c < 36) { ic = 4; jc = c - 33; }
    else if (c < 42) { ic = 5 + ((c - 36) >> 1); jc = (c - 36) & 1; } else { ic = 8 + (c - 42); jc = 0; }
    if (!valid) { ic = 0; jc = 0; }
  }
  for (int row = gw; row < M; row += nw) {
    const uint32_t* tk = topk + (size_t)row * 256;
    uint32_t ids0 = 0, ids1 = 0; float gw0 = 0.f, gw1 = 0.f;
#pragma unroll 1
    for (int h = 0; h < 8; ++h) {
      const uint32_t K1 = tk[(2 * h) * 16 + (lane & 15)], K2 = tk[(2 * h + 1) * 16 + (lane & 15)];
      const float s1 = ord_dec(__shfl(K1, ic) & ~0x7fu), s2 = ord_dec(__shfl(K2, jc) & ~0x7fu);
      const uint32_t flat = (uint32_t)(ic * 16 + jc);
      const uint32_t key = valid ? ((ord_key(s1 + s2) & ~0xffu) | (255u - flat)) : 0u;
      int rank = 0;
#pragma unroll
      for (int c = 0; c < 50; ++c) {
        const uint32_t kk = __builtin_amdgcn_readlane(key, c);
        rank += (kk > key) ? 1 : 0;
      }
      const uint32_t fsorted = __builtin_amdgcn_ds_permute(rank * 4, flat);
      const uint32_t fl = __shfl(fsorted, lane & 15);
      const uint32_t k1 = __shfl(K1, (int)(fl >> 4)), k2 = __shfl(K2, (int)(fl & 15));
      const float sc = ord_dec(k1 & ~0x7fu) + ord_dec(k2 & ~0x7fu);
      const uint32_t id = (127u - (k1 & 127u)) * 128u + (127u - (k2 & 127u));
      const float mx = __shfl(sc, 0);
      const float e = __expf(sc - mx);
      float se = e;
      se += __shfl_xor(se, 1); se += __shfl_xor(se, 2); se += __shfl_xor(se, 4); se += __shfl_xor(se, 8);
      const float gsm = e / se;
      if ((lane >> 4) == (h & 3)) { if (h < 4) { ids0 = id; gw0 = gsm; } else { ids1 = id; gw1 = gsm; } }
    }
    float hf[16];
    {
      const uint4 h0 = ((const uint4*)(xn + (size_t)row * DM))[2 * lane], h1 = ((const uint4*)(xn + (size_t)row * DM))[2 * lane + 1];
      const uint32_t hw[8] = {h0.x, h0.y, h0.z, h0.w, h1.x, h1.y, h1.z, h1.w};
#pragma unroll
      for (int i = 0; i < 8; ++i) { hf[2 * i] = bf_lo(hw[i]); hf[2 * i + 1] = bf_hi(hw[i]); }
    }
    float acc[16];
#pragma unroll
    for (int i = 0; i < 16; ++i) acc[i] = 0.f;
    uint4 U0[4], V0[4], U1[4], V1[4];
#if (DUP_MASK >> 8) & 1
    gw0 *= 0.5f; gw1 *= 0.5f;
#pragma unroll 1
    for (int rep = 0; rep < 2; ++rep) {
#endif
    peer_load4(PU, PV, ids0, 0, lane, U0, V0);
#pragma unroll 1
    for (int g2 = 0; g2 < 16; ++g2) {
      const int h = g2 >> 1, bl = (h & 3) * 16 + (g2 & 1) * 8;
      const uint32_t idsr = h < 4 ? ids0 : ids1;
      const float gwr = h < 4 ? gw0 : gw1;
      peer_load4(PU, PV, idsr, bl + 4, lane, U1, V1);
      peer_comp4(U0, V0, hf, gwr, bl, lane, acc);
      if (g2 < 15) {
        const int hn = (g2 + 1) >> 1, bn = (hn & 3) * 16 + ((g2 + 1) & 1) * 8;
        const uint32_t idn = hn < 4 ? ids0 : ids1;
        peer_load4(PU, PV, idn, bn, lane, U0, V0);
      }
      peer_comp4(U1, V1, hf, gwr, bl + 4, lane, acc);
    }
#if (DUP_MASK >> 8) & 1
    }
#endif
    float x[16], g2v[16];
    float* xr = xrow_ptr(p, row);
    load_row16(xr, lane, x);
    const int b = row_batch(row);
    load_row16(mod + (size_t)(l * 9 + b) * 6144 + 5120, lane, g2v);
#pragma unroll
    for (int i = 0; i < 16; ++i) x[i] += g2v[i] * acc[i];
    if (l < 3) {
      store_row16(xr, lane, x);
      const float* m = mod + (size_t)((l + 1) * 9 + b) * 6144;
      norm_mod_store(x, p.in[I_N1G] + (l + 1) * 1024, m, m + 1024, xn + (size_t)row * DM, lane);
    } else {
      float ss = 0.f;
#pragma unroll
      for (int i = 0; i < 16; ++i) ss += x[i] * x[i];
      ss = wave_sum(ss);
      const float rstd = rsqrtf(ss * (1.0f / 1024.0f) + 1e-6f);
      float fg[16];
      load_row16(p.in[I_FG], lane, fg);
#pragma unroll
      for (int i = 0; i < 16; ++i) x[i] = x[i] * rstd * fg[i];
      store_row16(xr, lane, x);
    }
  }
}


constexpr size_t OFF_PD  = OFF_BUF1;
constexpr size_t OFF_IDS = OFF_BUF2;
constexpr size_t OFF_GW  = OFF_IDS + (size_t)TT * 128 * 2;
constexpr size_t OFF_WW  = OFF_GW + (size_t)TT * 128 * 4;
static_assert(OFF_WW + (size_t)TT * 128 * 4 <= OFF_TOPK, "PEER scratch overflows BUF2");

template <int CTRL> __device__ __forceinline__ float dpp_f(float v) {
  return __uint_as_float((uint32_t)__builtin_amdgcn_update_dpp(0, (int)__float_as_uint(v), CTRL, 0xf, 0xf, true));
}

template <int CTRL> __device__ __forceinline__ uint32_t dpp_u(uint32_t v) {
  return (uint32_t)__builtin_amdgcn_update_dpp(0, (int)v, CTRL, 0xf, 0xf, true);
}
__device__ __forceinline__ uint32_t xor_lane(uint32_t x, int d, int lane) {
  switch (d) {
    case 1: return dpp_u<0xB1>(x);
    case 2: return dpp_u<0x4E>(x);
    case 4: return (uint32_t)__builtin_amdgcn_ds_swizzle((int)x, (4 << 10) | 0x1f);
    case 8: return (uint32_t)__builtin_amdgcn_ds_swizzle((int)x, (8 << 10) | 0x1f);
    case 16: return (uint32_t)__builtin_amdgcn_ds_swizzle((int)x, (16 << 10) | 0x1f);
    default: {
      auto r = __builtin_amdgcn_permlane32_swap(x, x, false, false);
      return lane < 32 ? r[1] : r[0];
    }
  }
}
__device__ __forceinline__ float xor_lane_f(float x, int d, int lane) { return __uint_as_float(xor_lane(__float_as_uint(x), d, lane)); }
__device__ __forceinline__ void phase_peer_combine(const Params& p, int M) {
  const int tid__ = tid_();
  const int lane = tid__ & 63, gw = blockIdx.x * 4 + (tid__ >> 6), nw = gridDim.x * 4;
  const uint32_t* topk = (const uint32_t*)(p.ws + OFF_TOPK);
  uint16_t* idsT = (uint16_t*)(p.ws + OFF_IDS);
  float* gwT = (float*)(p.ws + OFF_GW);
  int ic, jc; const bool valid = lane < 50;
  {
    const int c = lane;
    if (c < 16) { ic = 0; jc = c; } else if (c < 24) { ic = 1; jc = c - 16; } else if (c < 29) { ic = 2; jc = c - 24; }
    else if (c < 33) { ic = 3; jc = c - 29; } else if (c < 36) { ic = 4; jc = c - 33; }
    else if (c < 42) { ic = 5 + ((c - 36) >> 1); jc = (c - 36) & 1; } else { ic = 8 + (c - 42); jc = 0; }
    if (!valid) { ic = 0; jc = 0; }
  }
  const uint32_t flat = (uint32_t)(ic * 16 + jc);
  uint32_t KN[16];
  if (gw < M) {
#pragma unroll
    for (int i = 0; i < 16; ++i) KN[i] = topk[(size_t)gw * 256 + i * 16 + (lane & 15)];
  }
  for (int row = gw; row < M; row += nw) {
    uint32_t KC[16];
#pragma unroll
    for (int i = 0; i < 16; ++i) KC[i] = KN[i];
#pragma unroll
    for (int hg = 0; hg < 2; ++hg) {
      uint32_t K1[4], K2[4], key[4];
#pragma unroll
      for (int hh = 0; hh < 4; ++hh) {
        const int h = hg * 4 + hh;
        K1[hh] = KC[2 * h]; K2[hh] = KC[2 * h + 1];
      }
#pragma unroll
      for (int hh = 0; hh < 4; ++hh) {
        const float s1 = ord_dec(__shfl(K1[hh], ic) & ~0x7fu), s2 = ord_dec(__shfl(K2[hh], jc) & ~0x7fu);
        key[hh] = valid ? ((ord_key(s1 + s2) & ~0xffu) | (255u - flat)) : 0u;
      }
#pragma unroll
      for (int k = 2; k <= 64; k <<= 1) {
#pragma unroll
        for (int j = k >> 1; j > 0; j >>= 1) {
          const bool desc = (k == 64) ? true : ((lane & k) == 0);
          const bool lower = (lane & j) == 0;
          uint32_t pk[4];
#pragma unroll
          for (int hh = 0; hh < 4; ++hh) pk[hh] = xor_lane(key[hh], j, lane);
#pragma unroll
          for (int hh = 0; hh < 4; ++hh) {
            const uint32_t mx = max(key[hh], pk[hh]), mn = min(key[hh], pk[hh]);
            key[hh] = (desc == lower) ? mx : mn;
          }
        }
      }
      uint32_t k1[4], k2[4];
#pragma unroll
      for (int hh = 0; hh < 4; ++hh) {
        const uint32_t fl = 255u - (key[hh] & 255u);
        k1[hh] = __shfl(K1[hh], (int)(fl >> 4)); k2[hh] = __shfl(K2[hh], (int)(fl & 15));
      }
      float e[4], se[4];
#pragma unroll
      for (int hh = 0; hh < 4; ++hh) {
        const float sc = ord_dec(k1[hh] & ~0x7fu) + ord_dec(k2[hh] & ~0x7fu);
        const float mx = __uint_as_float(__builtin_amdgcn_readlane(__float_as_uint(sc), 0));
        e[hh] = __expf(sc - mx); se[hh] = e[hh];
      }
#pragma unroll
      for (int d = 1; d <= 8; d <<= 1) {
        float t4[4];
#pragma unroll
        for (int hh = 0; hh < 4; ++hh) t4[hh] = xor_lane_f(se[hh], d, lane);
#pragma unroll
        for (int hh = 0; hh < 4; ++hh) se[hh] += t4[hh];
      }
      if (lane < 16) {
#pragma unroll
        for (int hh = 0; hh < 4; ++hh) {
          const int h = hg * 4 + hh, k = lane, pos = (k & 7) * 16 + 2 * h + (k >> 3);
          const uint32_t id = (127u - (k1[hh] & 127u)) * 128u + (127u - (k2[hh] & 127u));
          idsT[(size_t)row * 128 + pos] = (uint16_t)id;
          gwT[(size_t)row * 128 + pos] = e[hh] / se[hh];
        }
      }
      if (hg == 0) {
        __builtin_amdgcn_sched_barrier(0);
        const uint32_t* tn = topk + (size_t)(row + nw < M ? row + nw : row) * 256 + (lane & 15);
#pragma unroll
        for (int i = 0; i < 16; ++i) KN[i] = tn[i * 16];
        __builtin_amdgcn_sched_barrier(0);
      }
    }
  }
}

typedef uint32_t u32x4v __attribute__((ext_vector_type(4)));
__device__ __forceinline__ uint4 ld_nt16(const void* p) { const u32x4v v = __builtin_nontemporal_load((const u32x4v*)p); return make_uint4(v.x, v.y, v.z, v.w); }
__device__ __forceinline__ float2 ld_nt8(const void* p) { const f32x2 v = __builtin_nontemporal_load((const f32x2*)p); return make_float2(v.x, v.y); }
__device__ __forceinline__ void st_nt8(void* p, float2 v) { const f32x2 t = {v.x, v.y}; __builtin_nontemporal_store(t, (f32x2*)p); }
__device__ __forceinline__ uint32_t peer_id16(const uint4& i0, const uint4& i1, int i) {
  const uint32_t iw[8] = {i0.x, i0.y, i0.z, i0.w, i1.x, i1.y, i1.z, i1.w};
  return (i & 1) ? (iw[i >> 1] >> 16) : (iw[i >> 1] & 0xffffu);
}
__device__ __forceinline__ void phase_peer_dots(const Params& p, int l, int M) {
  const int tid__ = tid_();
  const int lane = tid__ & 63, grp = lane >> 3, j = lane & 7;
  const int s = blockIdx.x & 7, worker = (blockIdx.x >> 3) * 4 + (tid__ >> 6), nworker = (gridDim.x >> 3) * 4;
  const uint16_t* idsT = (const uint16_t*)(p.ws + OFF_IDS) + grp * 16;
  const bf16_t* xn = (const bf16_t*)(p.ws + OFF_XN) + 128 * s + 16 * j;
  float* pd = (float*)(p.ws + OFF_PD) + (size_t)s * 128 + grp * 16 + 8 * (j & 1) + 4 * ((j >> 1) & 1) + 2 * (j >> 2);
  const uint8_t* PU = (const uint8_t*)(p.ws + OFF_PU) + ((size_t)l * 8 + s) * 16384 * 128 + 16 * j;
  const int last = M - 1;
  int row = worker;
  uint4 ia0 = *(const uint4*)(idsT + (size_t)row * 128), ia1 = *(const uint4*)(idsT + (size_t)row * 128 + 8);
  uint4 U[16];
#pragma unroll
  for (int i = 0; i < 16; ++i) U[i] = *(const uint4*)(PU + (size_t)peer_id16(ia0, ia1, i) * 128);
  uint4 h0 = *(const uint4*)(xn + (size_t)row * DM), h1 = *(const uint4*)(xn + (size_t)row * DM + 8);
  {
    const int rn = min(row + nworker, last);
    ia0 = *(const uint4*)(idsT + (size_t)rn * 128); ia1 = *(const uint4*)(idsT + (size_t)rn * 128 + 8);
  }
  for (; row < M; row += nworker) {
    const int rn = min(row + nworker, last), rnn = min(row + 2 * nworker, last);
    const uint4 ib0 = *(const uint4*)(idsT + (size_t)rnn * 128), ib1 = *(const uint4*)(idsT + (size_t)rnn * 128 + 8);
    const uint4 hn0 = *(const uint4*)(xn + (size_t)rn * DM), hn1 = *(const uint4*)(xn + (size_t)rn * DM + 8);
    f16x2 hh[8];
    {
      const uint32_t hw[8] = {h0.x, h0.y, h0.z, h0.w, h1.x, h1.y, h1.z, h1.w};
#pragma unroll
      for (int c = 0; c < 8; ++c) { hh[c].x = (_Float16)bf_lo(hw[c]); hh[c].y = (_Float16)bf_hi(hw[c]); }
    }
    float pp[16];
#pragma unroll
    for (int i = 0; i < 16; ++i) {
      const uint4 ur = U[i];
      U[i] = *(const uint4*)(PU + (size_t)peer_id16(ia0, ia1, i) * 128);
      const int uw[4] = {(int)ur.x, (int)ur.y, (int)ur.z, (int)ur.w};
      float sv = 0.f;
#pragma unroll
      for (int c = 0; c < 4; ++c) {
        sv = __builtin_amdgcn_fdot2(__builtin_bit_cast(f16x2, __builtin_amdgcn_cvt_scalef32_pk_f16_fp8(uw[c], 1.0f, false)), hh[2 * c], sv, false);
        sv = __builtin_amdgcn_fdot2(__builtin_bit_cast(f16x2, __builtin_amdgcn_cvt_scalef32_pk_f16_fp8(uw[c], 1.0f, true)), hh[2 * c + 1], sv, false);
      }
      pp[i] = sv;
      if ((i & 3) == 3) __builtin_amdgcn_sched_barrier(0);
    }
    float q[8], r[4], t2[2];
#pragma unroll
    for (int mm = 0; mm < 8; ++mm) {
      const float keep = (j & 1) ? pp[mm + 8] : pp[mm], send = (j & 1) ? pp[mm] : pp[mm + 8];
      q[mm] = keep + dpp_f<0xB1>(send);
    }
#pragma unroll
    for (int mm = 0; mm < 4; ++mm) {
      const float keep = (j & 2) ? q[mm + 4] : q[mm], send = (j & 2) ? q[mm] : q[mm + 4];
      r[mm] = keep + dpp_f<0x4E>(send);
    }
#pragma unroll
    for (int mm = 0; mm < 2; ++mm) {
      const float keep = (j & 4) ? r[mm + 2] : r[mm], send = (j & 4) ? r[mm] : r[mm + 2];
      t2[mm] = keep + __shfl_xor(send, 4);
    }
    st_nt8(pd + (size_t)row * 1024, make_float2(t2[0], t2[1]));
    ia0 = ib0; ia1 = ib1; h0 = hn0; h1 = hn1;
  }
}

__device__ __forceinline__ void phase_peer_weights(const Params& p, int M) {
  const int tid__ = tid_();
  const int lane = tid__ & 63, gw = blockIdx.x * 4 + (tid__ >> 6), nw = gridDim.x * 4;
  const float* pd = (const float*)(p.ws + OFF_PD) + 2 * lane;
  const float* gwT = (const float*)(p.ws + OFF_GW) + 2 * lane;
  _Float16* ww = (_Float16*)(p.ws + OFF_WW) + 2 * lane;
  if (gw >= M) return;
  float2 vn[8], gn;
#pragma unroll
  for (int s = 0; s < 8; ++s) vn[s] = *(const float2*)(pd + ((size_t)gw * 8 + s) * 128);
  gn = *(const float2*)(gwT + (size_t)gw * 128);
  f16x2 pw = {(_Float16)0.f, (_Float16)0.f};
  int prow = gw;
  for (int row = gw; row < M; row += nw) {
    float d0 = 0.f, d1 = 0.f;
#pragma unroll
    for (int s = 0; s < 8; ++s) { d0 += vn[s].x; d1 += vn[s].y; }
    const float2 g = gn;
    __builtin_amdgcn_sched_barrier(0);
    {
      *(f16x2*)(ww + (size_t)prow * 128) = pw;
      const int rn = row + nw < M ? row + nw : row;
#pragma unroll
      for (int s = 0; s < 8; ++s) vn[s] = *(const float2*)(pd + ((size_t)rn * 8 + s) * 128);
      gn = *(const float2*)(gwT + (size_t)rn * 128);
    }
    __builtin_amdgcn_sched_barrier(0);
    pw.x = (_Float16)(gelu_tanh(d0 * (1.0f / 32.0f)) * g.x * 32.0f);
    pw.y = (_Float16)(gelu_tanh(d1 * (1.0f / 32.0f)) * g.y * 32.0f);
    prow = row;
  }
  *(f16x2*)(ww + (size_t)prow * 128) = pw;
}

struct PeerMetaB { uint4 w0, w1; float2 x; };
__device__ __forceinline__ void phase_peer_values(const Params& p, int l, int M, bool dry) {
  const int tid__ = tid_();
  const int lane = tid__ & 63, grp = lane >> 3, j = lane & 7;
  const int s = blockIdx.x & 7, worker = (blockIdx.x >> 3) * 4 + (tid__ >> 6), nworker = (gridDim.x >> 3) * 4;
  const uint16_t* idsT = (const uint16_t*)(p.ws + OFF_IDS) + grp * 16;
  const _Float16* ww = (const _Float16*)(p.ws + OFF_WW) + grp * 16;
  const int col = 128 * s + 16 * j + 8 * ((lane >> 3) & 1) + 4 * ((lane >> 4) & 1) + 2 * ((lane >> 5) & 1);
  const float* mod = (const float*)(p.ws + OFF_MOD) + (size_t)l * 9 * 6144 + 5120 + col;
  const uint8_t* PV = (const uint8_t*)(p.ws + OFF_PV) + ((size_t)l * 8 + s) * 16384 * 128 + 16 * j;
  auto meta = [&](int r_) {
    PeerMetaB m;
    m.w0 = *(const uint4*)(ww + (size_t)r_ * 128); m.w1 = *(const uint4*)(ww + (size_t)r_ * 128 + 8);
    m.x = ld_nt8(xrow_ptr(p, r_) + col);
    return m;
  };
  const int last = M - 1;
  int row = worker;
  uint4 ia0 = *(const uint4*)(idsT + (size_t)row * 128), ia1 = *(const uint4*)(idsT + (size_t)row * 128 + 8);
  uint4 V[16];
#pragma unroll
  for (int i = 0; i < 16; ++i) V[i] = *(const uint4*)(PV + (size_t)peer_id16(ia0, ia1, i) * 128);
  PeerMetaB m = meta(row);
  {
    const int rn = min(row + nworker, last);
    ia0 = *(const uint4*)(idsT + (size_t)rn * 128); ia1 = *(const uint4*)(idsT + (size_t)rn * 128 + 8);
  }
  int gb = -1; float2 g2v = make_float2(0.f, 0.f);
  for (; row < M; row += nworker) {
    const int rn = min(row + nworker, last), rnn = min(row + 2 * nworker, last);
    const uint4 ib0 = *(const uint4*)(idsT + (size_t)rnn * 128), ib1 = *(const uint4*)(idsT + (size_t)rnn * 128 + 8);
    const PeerMetaB mn = meta(rn);
    const int b = row_batch(row);
    if (b != gb) { gb = b; g2v = *(const float2*)(mod + (size_t)b * 6144); }
    const uint32_t wp[8] = {m.w0.x, m.w0.y, m.w0.z, m.w0.w, m.w1.x, m.w1.y, m.w1.z, m.w1.w};
    f16x2 acc2[8];
#pragma unroll
    for (int c = 0; c < 8; ++c) acc2[c] = (f16x2){(_Float16)0.f, (_Float16)0.f};
#pragma unroll
    for (int i = 0; i < 16; ++i) {
      const uint4 vr = V[i];
      V[i] = *(const uint4*)(PV + (size_t)peer_id16(ia0, ia1, i) * 128);
      const int vw[4] = {(int)vr.x, (int)vr.y, (int)vr.z, (int)vr.w};
      const f16x2 wpair = __builtin_bit_cast(f16x2, wp[i >> 1]);
      const _Float16 wh = (i & 1) ? wpair.y : wpair.x;
      const f16x2 w2 = {wh, wh};
#pragma unroll
      for (int c = 0; c < 4; ++c) {
        const f16x2 va = __builtin_bit_cast(f16x2, __builtin_amdgcn_cvt_scalef32_pk_f16_fp8(vw[c], 1.0f, false));
        const f16x2 vb = __builtin_bit_cast(f16x2, __builtin_amdgcn_cvt_scalef32_pk_f16_fp8(vw[c], 1.0f, true));
        acc2[2 * c] = __builtin_elementwise_fma(w2, va, acc2[2 * c]);
        acc2[2 * c + 1] = __builtin_elementwise_fma(w2, vb, acc2[2 * c + 1]);
      }
      if ((i & 3) == 3) __builtin_amdgcn_sched_barrier(0);
    }
    float acc[16];
#pragma unroll
    for (int c = 0; c < 8; ++c) { acc[2 * c] = (float)acc2[c].x * (1.0f / 256.0f); acc[2 * c + 1] = (float)acc2[c].y * (1.0f / 256.0f); }
    float q[8], r[4], t2[2];
#pragma unroll
    for (int mm = 0; mm < 8; ++mm) {
      const float keep = (lane & 8) ? acc[mm + 8] : acc[mm], send = (lane & 8) ? acc[mm] : acc[mm + 8];
      q[mm] = keep + dpp_f<0x128>(send);
    }
#pragma unroll
    for (int mm = 0; mm < 4; ++mm) {
      const float keep = (lane & 16) ? q[mm + 4] : q[mm], send = (lane & 16) ? q[mm] : q[mm + 4];
      r[mm] = keep + __shfl_xor(send, 16);
    }
#pragma unroll
    for (int mm = 0; mm < 2; ++mm) {
      const float keep = (lane & 32) ? r[mm + 2] : r[mm], send = (lane & 32) ? r[mm] : r[mm + 2];
      t2[mm] = keep + __shfl_xor(send, 32);
    }
    float* xr = dry ? (float*)(p.ws + OFF_PD) + (size_t)row * 1024 + col : xrow_ptr(p, row) + col;
    st_nt8(xr, make_float2(m.x.x + g2v.x * t2[0], m.x.y + g2v.y * t2[1]));
    ia0 = ib0; ia1 = ib1; m = mn;
  }
}

__device__ __forceinline__ void phase_next_norm(const Params& p, int l, int M) {
  const int tid__ = tid_();
  const int lane = tid__ & 63, gw = blockIdx.x * 4 + (tid__ >> 6), nw = gridDim.x * 4;
  const float* mod = (const float*)(p.ws + OFF_MOD);
  bf16_t* xn = (bf16_t*)(p.ws + OFF_XN);
  if (l < 3) {
    row_norm_pass(p, tid__, M, p.in[I_N1G] + (l + 1) * 1024, mod + (size_t)(l + 1) * 9 * 6144, 0, 1024);
    return;
  }
  for (int row = gw; row < M; row += nw) {
    float x[16];
    float* xr = xrow_ptr(p, row);
    load_row16(xr, lane, x);
    {
      float ss = 0.f;
#pragma unroll
      for (int i = 0; i < 16; ++i) ss += x[i] * x[i];
      ss = wave_sum(ss);
      const float rstd = rsqrtf(ss * (1.0f / 1024.0f) + 1e-6f);
      float fg[16];
      load_row16(p.in[I_FG], lane, fg);
#pragma unroll
      for (int i = 0; i < 16; ++i) x[i] = x[i] * rstd * fg[i];
      store_row16(xr, lane, x);
    }
  }
}


constexpr size_t OFF_BAR = OFF_HN8;
__device__ __forceinline__ void fast_grid_barrier(unsigned* bar, unsigned epoch, int tid) {
  asm volatile("s_waitcnt vmcnt(0)" ::: "memory");
  __syncthreads();
  if (tid == 0) {
    __builtin_amdgcn_fence(__ATOMIC_RELEASE, "agent");
    const unsigned g = blockIdx.x & 7u, per = gridDim.x >> 3;
    const unsigned v = __hip_atomic_fetch_add(bar + g * 64, 1u, __ATOMIC_RELAXED, __HIP_MEMORY_SCOPE_AGENT) + 1u;
    if (v == epoch * per) {
      const unsigned t = __hip_atomic_fetch_add(bar + 8 * 64, 1u, __ATOMIC_RELAXED, __HIP_MEMORY_SCOPE_AGENT) + 1u;
      if (t == epoch * 8u) __hip_atomic_store(bar + 9 * 64, epoch, __ATOMIC_RELAXED, __HIP_MEMORY_SCOPE_AGENT);
    }
    while (__hip_atomic_load(bar + 9 * 64, __ATOMIC_RELAXED, __HIP_MEMORY_SCOPE_AGENT) < epoch) __builtin_amdgcn_s_sleep(1);
    __builtin_amdgcn_fence(__ATOMIC_ACQUIRE, "agent");
  }
  __syncthreads();
}

#ifndef DUP_MASK
#define DUP_MASK 0
#endif
#define SYNC fast_grid_barrier(bar, ++epoch, btid);
#define RUN(K, CALL) { CALL; if ((DUP_MASK >> (K)) & 1) { grid.sync(); CALL; } }
#define PEER(L, MM) \
  RUN(3, phase_norm2(p, L, MM)) SYNC \
  RUN(4, phase_peer_score(p, L, MM, sm)) SYNC \
  RUN(8, phase_peer_combine(p, MM)) SYNC \
  RUN(9, phase_peer_dots(p, L, MM)) SYNC \
  RUN(10, phase_peer_weights(p, MM)) SYNC \
  if ((DUP_MASK >> 12) & 1) { phase_peer_values(p, L, MM, true); grid.sync(); } \
  phase_peer_values(p, L, MM, false); SYNC \
  RUN(11, phase_next_norm(p, L, MM))
__global__ void __launch_bounds__(256, 2) mega_kernel(Params p) {
  __shared__ Smem sm;
  cg::grid_group grid = cg::this_grid();
  unsigned* bar = (unsigned*)(p.ws + OFF_BAR);
  unsigned epoch = 0;
  const int btid = (int)__builtin_amdgcn_workitem_id_x();
  RUN(0, phase_setup(p, sm))
  grid.sync();
  RUN(0, phase_modfin(p)) SYNC
  RUN(15, phase_first_norm(p)) SYNC
  RUN(1, phase_cm_in(p, 0, sm)) SYNC
  RUN(2, phase_cm_gate(p, 0, sm)) SYNC
  RUN(15, phase_cm_out(p, 0, 0, sm)) SYNC
  PEER(0, TT) SYNC
  RUN(5, phase_ssm_in(p, 0, sm)) SYNC
  RUN(6, phase_scan(p, 0, sm)) SYNC
  RUN(7, phase_ssm_comb(p, 0)) SYNC
  RUN(15, phase_ssm_out(p, 1, 0, TT, sm)) SYNC
  PEER(1, TT) SYNC
  RUN(1, phase_cm_in(p, 1, sm)) SYNC
  RUN(2, phase_cm_gate(p, 1, sm)) SYNC
  RUN(15, phase_cm_out(p, 2, 1, sm)) SYNC
  PEER(2, TT) SYNC
  RUN(5, phase_ssm_in(p, 1, sm)) SYNC
  RUN(6, phase_scan(p, 1, sm)) SYNC
  RUN(7, phase_ssm_comb(p, 1)) SYNC
  RUN(15, phase_ssm_out(p, 3, 1, TL, sm)) SYNC
  PEER(3, TL)
}

extern "C" void kernel_launch(void* const* d_in, const int* in_sizes, int n_in, void* d_out, int out_size, void* d_ws, size_t ws_size,
                              hipStream_t stream) {
  static int grid_blocks = 0;
  if (!grid_blocks) {
    int dev = 0, cus = 0, per_cu = 0;
    hipGetDevice(&dev);
    hipDeviceGetAttribute(&cus, hipDeviceAttributeMultiprocessorCount, dev);
    hipOccupancyMaxActiveBlocksPerMultiprocessor(&per_cu, mega_kernel, 256, 0);
    if (per_cu > 2) per_cu = 2;
    if (per_cu < 1) per_cu = 1;
    grid_blocks = cus * per_cu;
    grid_blocks -= grid_blocks % 8;
  }
  if (ws_size < WS_TOTAL) { fprintf(stderr, "workspace too small: %zu < %zu\n", ws_size, (size_t)WS_TOTAL); return; }
  Params p{};
  for (int i = 0; i < 29; ++i) p.in[i] = (const float*)d_in[i];
  p.out = (float*)d_out;
  p.ws = (unsigned char*)d_ws;
  hipMemsetAsync((unsigned char*)d_ws + OFF_BAR, 0, 4096, stream);
  void* args[] = {&p};
  hipError_t e = hipLaunchCooperativeKernel((void*)mega_kernel, dim3(grid_blocks), dim3(256), args, 0, stream);
  if (e != hipSuccess) fprintf(stderr, "cooperative launch failed: %s (grid %d)\n", hipGetErrorString(e), grid_blocks);
}
```

```cpp
#include <hip/hip_runtime.h>
#include <hip/hip_cooperative_groups.h>
#include <stdint.h>
#include <cstdio>
namespace cg = cooperative_groups;

#ifndef MULTI_LAUNCH
#define MULTI_LAUNCH 0
#endif

typedef short bf16x8 __attribute__((ext_vector_type(8)));
typedef float f32x16 __attribute__((ext_vector_type(16)));
typedef float f32x4 __attribute__((ext_vector_type(4)));
typedef __bf16 bf2 __attribute__((ext_vector_type(2)));
typedef uint16_t bf16_t;

constexpr int TL = 65536, TC = 2048, TT = TL + TC, DM = 1024;
constexpr int NPHASE = 29;

constexpr size_t OFF_HC   = 0;
constexpr size_t OFF_MODP = OFF_HC   + (size_t)TC * DM * 4;
constexpr size_t OFF_MOD  = OFF_MODP + (size_t)4 * 8 * 9 * 6144 * 4;
constexpr size_t OFF_PE   = OFF_MOD  + (size_t)4 * 9 * 6144 * 4;
constexpr size_t OFF_PART = OFF_PE   + (size_t)192 * 512 * 4;
constexpr size_t OFF_XN   = OFF_PART + (size_t)TT * 32 * 4;
constexpr size_t OFF_BUF1 = OFF_XN   + (size_t)TT * DM * 2;
constexpr size_t OFF_BUF2 = OFF_BUF1 + (size_t)TT * 2048 * 2;
constexpr size_t OFF_TOPK = OFF_BUF2 + (size_t)TT * DM * 2;
constexpr size_t OFF_WINC = OFF_TOPK + (size_t)TT * 256 * 4;
constexpr size_t OFF_WOUTC= OFF_WINC + (size_t)2 * 2048 * 1024 * 2;
constexpr size_t OFF_WINS = OFF_WOUTC+ (size_t)2 * 1024 * 1024 * 2;
constexpr size_t OFF_WOUTS= OFF_WINS + (size_t)2 * 1024 * 1024 * 2;
constexpr size_t OFF_WEFF = OFF_WOUTS+ (size_t)2 * 2048 * 1024 * 2;
constexpr size_t OFF_WS   = OFF_WEFF + (size_t)4 * 2048 * 1024 * 2;
constexpr size_t OFF_PU   = OFF_WS   + (size_t)2 * 8 * 128 * 128 * 2;
constexpr size_t OFF_PV   = OFF_PU   + (size_t)4 * 16384 * 1024 * 2;
constexpr size_t OFF_HN8  = OFF_PV + (size_t)4 * 16384 * 1024;
constexpr size_t WS_TOTAL = OFF_HN8 + (size_t)TT * 1024;

struct Params {
  const float* in[29];
  float* out;
  unsigned char* ws;
};
enum { I_X = 0, I_C, I_CTX, I_CCTX, I_ADAW, I_ADAB, I_N1G, I_N2G, I_FG, I_CMWIN, I_CMLNG, I_CMLNB, I_CMWS, I_CMBS,
       I_CMWOUT, I_SWIN, I_LRE, I_LIM, I_LSTEP, I_BRE, I_BIM, I_CRE, I_CIM, I_SD, I_SWOUT, I_PWQ, I_PKEYS, I_PU, I_PV };

__device__ __forceinline__ int threadIdx_x_raw() { return (int)__builtin_amdgcn_workitem_id_x(); }
__device__ __forceinline__ uint32_t pack_bf16(float a, float b) {
  bf2 v; v[0] = (__bf16)a; v[1] = (__bf16)b; return __builtin_bit_cast(uint32_t, v);
}
__device__ __forceinline__ float bf_lo(uint32_t w) { return __uint_as_float(w << 16); }
__device__ __forceinline__ float bf_hi(uint32_t w) { return __uint_as_float(w & 0xffff0000u); }
__device__ __forceinline__ float fast_rcp(float x) { return __builtin_amdgcn_rcpf(x); }
__device__ __forceinline__ float gelu_tanh(float x) {
  float u = 0.7978845608028654f * (x + 0.044715f * x * x * x);
  float e = __expf(-2.0f * u);
  return x * fast_rcp(1.0f + e);
}
__device__ __forceinline__ float sigmoidf_(float x) { return fast_rcp(1.0f + __expf(-x)); }
__device__ __forceinline__ float siluf_(float x) { return x / (1.0f + expf(-x)); }
__device__ __forceinline__ uint32_t ord_key(float f) {
  uint32_t b = __float_as_uint(f);
  return b ^ ((b >> 31) ? 0xffffffffu : 0x80000000u);
}
__device__ __forceinline__ float ord_dec(uint32_t o) {
  uint32_t b = (o & 0x80000000u) ? (o ^ 0x80000000u) : ~o;
  return __uint_as_float(b);
}
__device__ __forceinline__ float wave_sum(float v) {
#pragma unroll
  for (int o = 32; o > 0; o >>= 1) v += __shfl_xor(v, o);
  return v;
}
__device__ __forceinline__ float* xrow_ptr(const Params& p, int row) {
  return row < TL ? p.out + (size_t)row * DM : (float*)(p.ws + OFF_HC) + (size_t)(row - TL) * DM;
}
__device__ __forceinline__ int row_batch(int row) { return row < TL ? (row >> 13) : 8; }

__device__ __forceinline__ int tid_() { int t = threadIdx_x_raw(); asm volatile("" : "+v"(t)); return t; }
struct __attribute__((aligned(16))) Smem {
  uint4 a[2][1024];
  uint4 b[2][1024];
};
__device__ __forceinline__ int lds_idx(int row, int ch) { return row * 8 + (ch ^ ((row >> 1) & 7)); }

__device__ __forceinline__ void compute_ktile(int tid__, const Smem& sm, int buf, f32x16 (&acc)[2][2]) {
  const int lane = tid__ & 63, w = tid__ >> 6, wr = w >> 1, wc = w & 1;
  const int swz = ((lane & 31) >> 1) & 7;
#pragma unroll
  for (int ks = 0; ks < 4; ++ks) {
    const int ch = (ks * 2 + (lane >> 5)) ^ swz;
    bf16x8 af[2], bfr[2];
#pragma unroll
    for (int mi = 0; mi < 2; ++mi) {
      uint4 v = sm.a[buf][(wr * 64 + mi * 32 + (lane & 31)) * 8 + ch];
      af[mi] = *(bf16x8*)&v;
    }
#pragma unroll
    for (int ni = 0; ni < 2; ++ni) {
      uint4 v = sm.b[buf][(wc * 64 + ni * 32 + (lane & 31)) * 8 + ch];
      bfr[ni] = *(bf16x8*)&v;
    }
#pragma unroll
    for (int mi = 0; mi < 2; ++mi)
#pragma unroll
      for (int ni = 0; ni < 2; ++ni)
        acc[mi][ni] = __builtin_amdgcn_mfma_f32_32x32x16_bf16(bfr[ni], af[mi], acc[mi][ni], 0, 0, 0);
  }
}

struct Stage8 { uint4 a0, a1, a2, a3, b0, b1, b2, b3; };
__device__ __forceinline__ Stage8 g_load(const bf16_t* ga, const bf16_t* gb, int lda, int ldb, int kt) {
  Stage8 s;
  s.a0 = *(const uint4*)(ga + kt * 64);
  s.a1 = *(const uint4*)(ga + (size_t)32 * lda + kt * 64);
  s.a2 = *(const uint4*)(ga + (size_t)64 * lda + kt * 64);
  s.a3 = *(const uint4*)(ga + (size_t)96 * lda + kt * 64);
  s.b0 = *(const uint4*)(gb + kt * 64);
  s.b1 = *(const uint4*)(gb + (size_t)32 * ldb + kt * 64);
  s.b2 = *(const uint4*)(gb + (size_t)64 * ldb + kt * 64);
  s.b3 = *(const uint4*)(gb + (size_t)96 * ldb + kt * 64);
  return s;
}
__device__ __forceinline__ void g_store(const Stage8& s, Smem& sm, int buf, int sidx) {
  sm.a[buf][sidx] = s.a0; sm.a[buf][sidx + 256] = s.a1; sm.a[buf][sidx + 512] = s.a2; sm.a[buf][sidx + 768] = s.a3;
  sm.b[buf][sidx] = s.b0; sm.b[buf][sidx + 256] = s.b1; sm.b[buf][sidx + 512] = s.b2; sm.b[buf][sidx + 768] = s.b3;
}
__device__ __forceinline__ void gemm_tile(int tid__, const bf16_t* __restrict__ A, int lda, const bf16_t* __restrict__ Bt, int ldb,
                                          int nk, Smem& sm, f32x16 (&acc)[2][2]) {
  const int t = tid__, lr = t >> 3, lc = t & 7;
  const bf16_t* ga = A + (size_t)lr * lda + lc * 8;
  const bf16_t* gb = Bt + (size_t)lr * ldb + lc * 8;
  const int sidx = lds_idx(lr, lc);
  Stage8 r0 = g_load(ga, gb, lda, ldb, 0);
  Stage8 r1 = g_load(ga, gb, lda, ldb, 1);
  g_store(r0, sm, 0, sidx);
  __syncthreads();
  for (int kt = 0; kt < nk - 2; kt += 2) {
    r0 = g_load(ga, gb, lda, ldb, kt + 2);
    compute_ktile(tid__, sm, 0, acc);
    g_store(r1, sm, 1, sidx);
    __syncthreads();
    r1 = g_load(ga, gb, lda, ldb, kt + 3);
    compute_ktile(tid__, sm, 1, acc);
    g_store(r0, sm, 0, sidx);
    __syncthreads();
  }
  compute_ktile(tid__, sm, 0, acc);
  g_store(r1, sm, 1, sidx);
  __syncthreads();
  compute_ktile(tid__, sm, 1, acc);
  __syncthreads();
}

template <class Epi>
__device__ __forceinline__ void gemm_phase(int tid__, const bf16_t* A, const bf16_t* Bt, int Mtiles, int NT, Smem& sm, Epi epi) {
  const int ntiles = Mtiles * NT;
  const int perm = (blockIdx.x & 7) * (gridDim.x >> 3) + (blockIdx.x >> 3);
  for (int base = 0; base < ntiles; base += gridDim.x) {
    const int v = base + perm;
    if (v >= ntiles) continue;
    int mt, nt;
    if (NT == 16) {
      const int half_tiles = Mtiles * 8, hf = v >= half_tiles ? 1 : 0, vv = v - hf * half_tiles;
      mt = vv >> 3; nt = hf * 8 + (vv & 7);
    } else { mt = v / NT; nt = v - mt * NT; }
    f32x16 acc[2][2];
#pragma unroll
    for (int mi = 0; mi < 2; ++mi)
#pragma unroll
      for (int ni = 0; ni < 2; ++ni)
#pragma unroll
        for (int r = 0; r < 16; ++r) acc[mi][ni][r] = 0.f;
    gemm_tile(tid__, A + (size_t)mt * 128 * DM, DM, Bt + (size_t)nt * 128 * DM, DM, 16, sm, acc);
    epi(acc, mt, nt);
    __syncthreads();
  }
}

__device__ __forceinline__ void cex_desc(uint32_t& a, uint32_t& b) { uint32_t mx = max(a, b), mn = min(a, b); a = mx; b = mn; }
__device__ __forceinline__ void sort16_desc(uint32_t (&v)[16]) {
#pragma unroll
  for (int k = 2; k <= 16; k <<= 1) {
#pragma unroll
    for (int j = k >> 1; j > 0; j >>= 1) {
#pragma unroll
      for (int i = 0; i < 16; ++i) {
        const int l = i ^ j;
        if (l > i) {
          if ((i & k) == 0) cex_desc(v[i], v[l]); else cex_desc(v[l], v[i]);
        }
      }
    }
  }
}
__device__ __forceinline__ void merge16_desc(uint32_t (&v)[16]) {
#pragma unroll
  for (int j = 8; j > 0; j >>= 1) {
#pragma unroll
    for (int i = 0; i < 16; ++i) {
      const int l = i ^ j;
      if (l > i) cex_desc(v[i], v[l]);
    }
  }
}

__device__ __forceinline__ void phase_setup(const Params& p, Smem& sm) {
  const int tid__ = tid_();
  const int tid = tid__, gtid = blockIdx.x * 256 + tid, gsz = gridDim.x * 256;
  {
    const size_t n16 = (size_t)4 * 16384 * 1024 / 16;
    for (int which = 0; which < 2; ++which) {
      const float4* src = (const float4*)p.in[which ? I_PV : I_PU];
      uint4* dst = (uint4*)(p.ws + (which ? OFF_PV : OFF_PU));
      const float sc = which ? 8.0f : 32.0f;
      for (size_t i = gtid; i < n16; i += gsz) {
        uint32_t o[4];
#pragma unroll
        for (int j = 0; j < 4; ++j) {
          const float4 a = src[4 * i + j];
          int w = 0;
          w = __builtin_amdgcn_cvt_pk_fp8_f32(a.x * sc, a.y * sc, w, false);
          w = __builtin_amdgcn_cvt_pk_fp8_f32(a.z * sc, a.w * sc, w, true);
          o[j] = (uint32_t)w;
        }
        const size_t e = i >> 6;
        const int piece = (int)(i & 63), slab = piece >> 3, sub = piece & 7;
        const size_t layer = e >> 14, ex = e & 16383;
        dst[((layer * 8 + slab) * 16384 + ex) * 8 + sub] = make_uint4(o[0], o[1], o[2], o[3]);
      }
    }
  }
  {
    for (int seg = 0; seg < 4; ++seg) {
      const int N = (seg == 0 || seg == 3) ? 2048 : 1024;
      const float* W = p.in[seg == 0 ? I_CMWIN : seg == 1 ? I_CMWOUT : seg == 2 ? I_SWIN : I_SWOUT];
      bf16_t* O = (bf16_t*)(p.ws + (seg == 0 ? OFF_WINC : seg == 1 ? OFF_WOUTC : seg == 2 ? OFF_WINS : OFF_WOUTS));
      const int total = 2 * N * 128;
      for (int i = gtid; i < total; i += gsz) {
        const int n = i % N, k8 = (i / N) % 128, m = i / (N * 128);
        int srcn = n;
        if (seg == 3) { const int tt = n >> 6, c = n & 63; srcn = c < 32 ? tt * 32 + c : 1024 + tt * 32 + (c - 32); }
        const float* s = W + (size_t)m * 1024 * N + (size_t)k8 * 8 * N + srcn;
        float f[8];
#pragma unroll
        for (int j = 0; j < 8; ++j) f[j] = s[(size_t)j * N];
        uint4 o; o.x = pack_bf16(f[0], f[1]); o.y = pack_bf16(f[2], f[3]); o.z = pack_bf16(f[4], f[5]); o.w = pack_bf16(f[6], f[7]);
        *(uint4*)(O + (size_t)m * N * 1024 + (size_t)n * 1024 + k8 * 8) = o;
      }
    }
    {
      const float4* src = (const float4*)p.in[I_CMWS];
      uint4* dst = (uint4*)(p.ws + OFF_WS);
      const int n8 = 2 * 8 * 128 * 128 / 8;
      for (int i = gtid; i < n8; i += gsz) {
        float4 a = src[2 * i], b = src[2 * i + 1];
        uint4 o; o.x = pack_bf16(a.x, a.y); o.y = pack_bf16(a.z, a.w); o.z = pack_bf16(b.x, b.y); o.w = pack_bf16(b.z, b.w);
        dst[i] = o;
      }
    }
  }
  {
    float* pe = (float*)(p.ws + OFF_PE);
    for (int i = gtid; i < 192 * 512; i += gsz) {
      const int pr = i >> 9, dd = i & 511, j = dd & 255;
      const float pos = (float)(pr < 128 ? pr : pr - 128);
      const float omega = 1.0f / powf(10000.0f, (float)j / 256.0f);
      const float ang = pos * omega;
      pe[i] = dd < 256 ? sinf(ang) : cosf(ang);
    }
  }
  {
    const int lane = tid & 63, gw = blockIdx.x * 4 + (tid >> 6), nw = gridDim.x * 4;
    bf16_t* weff = (bf16_t*)(p.ws + OFF_WEFF);
    for (int wt = gw; wt < 8192; wt += nw) {
      const int l = wt >> 11, rem = wt & 2047, hk = rem >> 7, mb = (rem >> 5) & 3, db = rem & 31;
      const float* ap = p.in[I_PWQ] + (size_t)l * 1024 * 4096 + (size_t)(db * 32 + (lane & 31)) * 4096 + hk * 256 + (lane >> 5) * 128;
      const float* bp = p.in[I_PKEYS] + ((size_t)(l * 16 + hk) * 128 + mb * 32 + (lane & 31)) * 256 + (lane >> 5) * 128;
      f32x16 acc;
#pragma unroll
      for (int r = 0; r < 16; ++r) acc[r] = 0.f;
      for (int s = 0; s < 128; s += 4) {
        const float4 av = *(const float4*)(ap + s), bv = *(const float4*)(bp + s);
        acc = __builtin_amdgcn_mfma_f32_32x32x2f32(av.x, bv.x, acc, 0, 0, 0);
        acc = __builtin_amdgcn_mfma_f32_32x32x2f32(av.y, bv.y, acc, 0, 0, 0);
        acc = __builtin_amdgcn_mfma_f32_32x32x2f32(av.z, bv.z, acc, 0, 0, 0);
        acc = __builtin_amdgcn_mfma_f32_32x32x2f32(av.w, bv.w, acc, 0, 0, 0);
      }
      bf16_t* o = weff + ((size_t)l * 2048 + hk * 128 + mb * 32 + (lane & 31)) * 1024 + db * 32 + 4 * (lane >> 5);
#pragma unroll
      for (int g = 0; g < 4; ++g) {
        uint2 v; v.x = pack_bf16(acc[4 * g], acc[4 * g + 1]); v.y = pack_bf16(acc[4 * g + 2], acc[4 * g + 3]);
        *(uint2*)(o + 8 * g) = v;
      }
    }
  }
  {
    float* sbuf = (float*)&sm;
    float* modp = (float*)(p.ws + OFF_MODP);
    for (int it = blockIdx.x; it < 4 * 24 * 8; it += gridDim.x) {
      const int l = it / 192, nb = (it / 8) % 24, sl = it & 7;
      __syncthreads();
      for (int i = tid; i < 9 * 128; i += 256) {
        const int r = i >> 7, d = sl * 128 + (i & 127);
        const float cv = r < 8 ? p.in[I_C][r * 1024 + d] : p.in[I_CCTX][d];
        sbuf[i] = siluf_(cv);
      }
      __syncthreads();
      const int n = nb * 256 + tid;
      const float* w = p.in[I_ADAW] + (size_t)l * 1024 * 6144 + (size_t)sl * 128 * 6144 + n;
      float acc[9];
#pragma unroll
      for (int r = 0; r < 9; ++r) acc[r] = 0.f;
      for (int d = 0; d < 128; ++d) {
        const float wv = w[(size_t)d * 6144];
#pragma unroll
        for (int r = 0; r < 9; ++r) acc[r] += sbuf[r * 128 + d] * wv;
      }
#pragma unroll
      for (int r = 0; r < 9; ++r) modp[((size_t)(l * 8 + sl) * 9 + r) * 6144 + n] = acc[r];
    }
    __syncthreads();
  }
}

__device__ __forceinline__ void phase_modfin(const Params& p) {
  const int tid__ = tid_();
  const int gtid = blockIdx.x * 256 + tid__, gsz = gridDim.x * 256;
  const float* modp = (const float*)(p.ws + OFF_MODP);
  float* mod = (float*)(p.ws + OFF_MOD);
  for (int i = gtid; i < 4 * 9 * 6144; i += gsz) {
    const int n = i % 6144, r = (i / 6144) % 9, l = i / (9 * 6144);
    float s = p.in[I_ADAB][l * 6144 + n];
#pragma unroll
    for (int sl = 0; sl < 8; ++sl) s += modp[((size_t)(l * 8 + sl) * 9 + r) * 6144 + n];
    mod[i] = s;
  }
}

__device__ __forceinline__ void load_row16(const float* src, int lane, float (&v)[16]) {
  const float4* s = (const float4*)src + lane * 4;
  float4 a = s[0], b = s[1], c = s[2], d = s[3];
  v[0] = a.x; v[1] = a.y; v[2] = a.z; v[3] = a.w; v[4] = b.x; v[5] = b.y; v[6] = b.z; v[7] = b.w;
  v[8] = c.x; v[9] = c.y; v[10] = c.z; v[11] = c.w; v[12] = d.x; v[13] = d.y; v[14] = d.z; v[15] = d.w;
}
__device__ __forceinline__ void store_row16(float* dst, int lane, const float (&v)[16]) {
  float4* s = (float4*)dst + lane * 4;
  s[0] = make_float4(v[0], v[1], v[2], v[3]); s[1] = make_float4(v[4], v[5], v[6], v[7]);
  s[2] = make_float4(v[8], v[9], v[10], v[11]); s[3] = make_float4(v[12], v[13], v[14], v[15]);
}
__device__ __forceinline__ void norm_mod_store(const float (&x)[16], const float* g, const float* sh, const float* sc, bf16_t* dst, int lane,
                                               uint8_t* dst8 = nullptr) {
  float ss = 0.f;
#pragma unroll
  for (int i = 0; i < 16; ++i) ss += x[i] * x[i];
  ss = wave_sum(ss);
  const float rstd = rsqrtf(ss * (1.0f / 1024.0f) + 1e-6f);
  float gv[16], sv[16], cv[16];
  load_row16(g, lane, gv); load_row16(sh, lane, sv); load_row16(sc, lane, cv);
  float y[16];
#pragma unroll
  for (int i = 0; i < 16; ++i) y[i] = x[i] * rstd * gv[i] * (1.0f + cv[i]) + sv[i];
  uint4 o0, o1;
  o0.x = pack_bf16(y[0], y[1]); o0.y = pack_bf16(y[2], y[3]); o0.z = pack_bf16(y[4], y[5]); o0.w = pack_bf16(y[6], y[7]);
  o1.x = pack_bf16(y[8], y[9]); o1.y = pack_bf16(y[10], y[11]); o1.z = pack_bf16(y[12], y[13]); o1.w = pack_bf16(y[14], y[15]);
  ((uint4*)dst)[2 * lane] = o0; ((uint4*)dst)[2 * lane + 1] = o1;
  if (dst8) {
    uint32_t w[4];
#pragma unroll
    for (int j = 0; j < 4; ++j) {
      int t = 0;
      t = __builtin_amdgcn_cvt_pk_fp8_f32(y[4 * j], y[4 * j + 1], t, false);
      t = __builtin_amdgcn_cvt_pk_fp8_f32(y[4 * j + 2], y[4 * j + 3], t, true);
      w[j] = (uint32_t)t;
    }
    ((uint4*)dst8)[lane] = make_uint4(w[0], w[1], w[2], w[3]);
  }
}


__device__ __forceinline__ void row_norm_pass(const Params& p, int tid__, int M, const float* g, const float* modl, int off_sh, int off_sc) {
  const int lane = tid__ & 63, gw = blockIdx.x * 4 + (tid__ >> 6), nw = gridDim.x * 4;
  bf16_t* xn = (bf16_t*)(p.ws + OFF_XN);
  if (gw >= M) return;
  float gv[16], w1[16], sh[16];
  load_row16(g, lane, gv);
  int cb = -1;
  float xnext[16];
  load_row16(xrow_ptr(p, gw), lane, xnext);
  uint4 po0 = make_uint4(0u, 0u, 0u, 0u), po1 = po0;
  int prow = gw;
  for (int row = gw; row < M; row += nw) {
    float x[16];
#pragma unroll
    for (int i = 0; i < 16; ++i) x[i] = xnext[i];
    float ss = 0.f;
#pragma unroll
    for (int i = 0; i < 16; ++i) ss += x[i] * x[i];
    __builtin_amdgcn_sched_barrier(0);
    {
      uint4* d = (uint4*)(xn + (size_t)prow * DM);
      d[2 * lane] = po0; d[2 * lane + 1] = po1;
      load_row16(xrow_ptr(p, row + nw < M ? row + nw : row), lane, xnext);
    }
    __builtin_amdgcn_sched_barrier(0);
    const int b = row_batch(row);
    if (b != cb) {
      cb = b;
      float cv[16];
      load_row16(modl + (size_t)b * 6144 + off_sc, lane, cv);
      load_row16(modl + (size_t)b * 6144 + off_sh, lane, sh);
#pragma unroll
      for (int i = 0; i < 16; ++i) w1[i] = gv[i] * (1.0f + cv[i]);
    }
    ss = wave_sum(ss);
    const float rstd = rsqrtf(ss * (1.0f / 1024.0f) + 1e-6f);
    float y[16];
#pragma unroll
    for (int i = 0; i < 16; ++i) y[i] = x[i] * rstd * w1[i] + sh[i];
    po0.x = pack_bf16(y[0], y[1]); po0.y = pack_bf16(y[2], y[3]); po0.z = pack_bf16(y[4], y[5]); po0.w = pack_bf16(y[6], y[7]);
    po1.x = pack_bf16(y[8], y[9]); po1.y = pack_bf16(y[10], y[11]); po1.z = pack_bf16(y[12], y[13]); po1.w = pack_bf16(y[14], y[15]);
    prow = row;
  }
  uint4* d = (uint4*)(xn + (size_t)prow * DM);
  d[2 * lane] = po0; d[2 * lane + 1] = po1;
}
__device__ __forceinline__ void phase_first_norm(const Params& p) {
  const int tid__ = tid_();
  const int lane = tid__ & 63, gw = blockIdx.x * 4 + (tid__ >> 6), nw = gridDim.x * 4;
  const float* pe = (const float*)(p.ws + OFF_PE);
  const float* mod = (const float*)(p.ws + OFF_MOD);
  bf16_t* xn = (bf16_t*)(p.ws + OFF_XN);
  for (int row = gw; row < TT; row += nw) {
    float x[16];
    if (row < TL) {
      load_row16(p.in[I_X] + (size_t)row * DM, lane, x);
      const int tkn = row & 8191, gr = tkn >> 6, gc = tkn & 63;
      const float* pp = lane < 32 ? pe + gr * 512 + 16 * lane : pe + (128 + gc) * 512 + 16 * lane - 512;
      float pv[16];
      load_row16(pp - 16 * lane, lane, pv);
#pragma unroll
      for (int i = 0; i < 16; ++i) x[i] += pv[i];
    } else {
      load_row16(p.in[I_CTX] + (size_t)(row - TL) * DM, lane, x);
    }
    store_row16(xrow_ptr(p, row), lane, x);
    const float* m = mod + (size_t)(0 * 9 + row_batch(row)) * 6144;
    norm_mod_store(x, p.in[I_N1G], m, m + 1024, xn + (size_t)row * DM, lane);
  }
}

__device__ __forceinline__ void phase_norm2(const Params& p, int l, int M) {
  const int tid__ = tid_();
  row_norm_pass(p, tid__, M, p.in[I_N2G] + l * 1024, (const float*)(p.ws + OFF_MOD) + (size_t)l * 9 * 6144, 3072, 4096);
}

__device__ __forceinline__ void phase_cm_in(const Params& p, int k, Smem& sm) {
  const int tid__ = tid_();
  bf16_t* Z = (bf16_t*)(p.ws + OFF_BUF1);
  float* part = (float*)(p.ws + OFF_PART);
  const int lane = tid__ & 63, w = tid__ >> 6, wr = w >> 1, wc = w & 1;
  gemm_phase(tid__, (const bf16_t*)(p.ws + OFF_XN), (const bf16_t*)(p.ws + OFF_WINC) + (size_t)k * 2048 * 1024, TT / 128, 16, sm,
    [&](f32x16 (&acc)[2][2], int mt, int nt) {
#pragma unroll
      for (int mi = 0; mi < 2; ++mi) {
        const int row = mt * 128 + wr * 64 + mi * 32 + (lane & 31);
        float s = 0.f, s2 = 0.f;
#pragma unroll
        for (int ni = 0; ni < 2; ++ni) {
          const int col = nt * 128 + wc * 64 + ni * 32 + 4 * (lane >> 5);
#pragma unroll
          for (int g = 0; g < 4; ++g) {
            float v0 = gelu_tanh(acc[mi][ni][4 * g]), v1 = gelu_tanh(acc[mi][ni][4 * g + 1]);
            float v2 = gelu_tanh(acc[mi][ni][4 * g + 2]), v3 = gelu_tanh(acc[mi][ni][4 * g + 3]);
            s += (v0 + v1) + (v2 + v3);
            s2 += (v0 * v0 + v1 * v1) + (v2 * v2 + v3 * v3);
            uint2 o; o.x = pack_bf16(v0, v1); o.y = pack_bf16(v2, v3);
            *(uint2*)(Z + (size_t)row * 2048 + col + 8 * g) = o;
          }
        }
        if (nt >= 8) {
          s += __shfl_xor(s, 32); s2 += __shfl_xor(s2, 32);
          if (lane < 32) *(float2*)(part + (size_t)row * 32 + ((nt - 8) * 2 + wc) * 2) = make_float2(s, s2);
        }
      }
    });
}

constexpr int STG_ROWB = 272;
__device__ __forceinline__ void phase_cm_gate(const Params& p, int k, Smem& sm) {
  const int tid__ = tid_();
  __shared__ float stat[128][2];
  const bf16_t* Z = (const bf16_t*)(p.ws + OFF_BUF1);
  bf16_t* UV = (bf16_t*)(p.ws + OFF_BUF2);
  const float* part = (const float*)(p.ws + OFF_PART);
  const bf16_t* WSb = (const bf16_t*)(p.ws + OFF_WS) + (size_t)k * 8 * 128 * 128;
  const float* lng = p.in[I_CMLNG] + k * 1024;
  const float* lnb = p.in[I_CMLNB] + k * 1024;
  const float* bs = p.in[I_CMBS] + k * 8 * 128;
  const int t = tid__, lane = t & 63, w = t >> 6, wr = w >> 1, wc = w & 1;
  const int ntiles = (TT / 128) * 8;
  for (int tile = blockIdx.x; tile < ntiles; tile += gridDim.x) {
    const int c = tile >> 3, h = tile & 7;
    if (t < 128) {
      const float4* pp = (const float4*)(part + (size_t)(c * 128 + t) * 32);
      float s = 0.f, s2 = 0.f;
#pragma unroll
      for (int i = 0; i < 8; ++i) { float4 v = pp[i]; s += v.x + v.z; s2 += v.y + v.w; }
      const float mu = s * (1.0f / 1024.0f);
      const float var = fmaxf(s2 * (1.0f / 1024.0f) - mu * mu, 0.f);
      stat[t][0] = mu; stat[t][1] = rsqrtf(var + 1e-6f);
    }
    {
      const int lr = t >> 3, lc = t & 7;
      const bf16_t* ga = WSb + (size_t)h * 128 * 128 + (size_t)lr * 128 + lc * 8;
#pragma unroll
      for (int kt = 0; kt < 2; ++kt)
#pragma unroll
        for (int i = 0; i < 4; ++i)
          sm.a[kt][lds_idx(lr + 32 * i, lc)] = *(const uint4*)(ga + (size_t)i * 32 * 128 + kt * 64);
    }
    {
      const int c16 = t & 15, d0 = c16 * 8;
      uint4 raw[8];
#pragma unroll
      for (int i = 0; i < 8; ++i) raw[i] = *(const uint4*)(Z + (size_t)(c * 128 + (t >> 4) + 16 * i) * 2048 + 1024 + h * 128 + d0);
      const float4 g0 = *(const float4*)(lng + h * 128 + d0), g1 = *(const float4*)(lng + h * 128 + d0 + 4);
      const float4 b0 = *(const float4*)(lnb + h * 128 + d0), b1 = *(const float4*)(lnb + h * 128 + d0 + 4);
      const float gg[8] = {g0.x, g0.y, g0.z, g0.w, g1.x, g1.y, g1.z, g1.w};
      const float bb[8] = {b0.x, b0.y, b0.z, b0.w, b1.x, b1.y, b1.z, b1.w};
      __syncthreads();
#pragma unroll
      for (int i = 0; i < 8; ++i) {
        const int q = (t >> 4) + 16 * i, kq = q & 63;
        const float mu = stat[q][0], rstd = stat[q][1];
        bf16_t* bl = (bf16_t*)&sm.b[q >> 6][0];
        const uint32_t wv[4] = {raw[i].x, raw[i].y, raw[i].z, raw[i].w};
#pragma unroll
        for (int e = 0; e < 8; ++e) {
          const float v = (e & 1) ? bf_hi(wv[e >> 1]) : bf_lo(wv[e >> 1]);
          const float y = (v - mu) * rstd * gg[e] + bb[e];
          bl[(size_t)lds_idx(d0 + e, kq >> 3) * 8 + (kq & 7)] = (bf16_t)(pack_bf16(y, y) & 0xffff);
        }
      }
    }
    __syncthreads();
    f32x16 acc[2][2];
#pragma unroll
    for (int mi = 0; mi < 2; ++mi)
#pragma unroll
      for (int ni = 0; ni < 2; ++ni)
#pragma unroll
        for (int r = 0; r < 16; ++r) acc[mi][ni][r] = 0.f;
    compute_ktile(tid__, sm, 0, acc);
    compute_ktile(tid__, sm, 1, acc);
    __syncthreads();
    {
      unsigned char* l = (unsigned char*)&sm;
#pragma unroll
      for (int mi = 0; mi < 2; ++mi) {
        const int pl = wr * 64 + mi * 32 + (lane & 31);
        const float bsv = bs[h * 128 + pl];
#pragma unroll
        for (int ni = 0; ni < 2; ++ni) {
          const int col = wc * 64 + ni * 32 + 4 * (lane >> 5);
#pragma unroll
          for (int g = 0; g < 4; ++g) {
            uint2 o; o.x = pack_bf16(acc[mi][ni][4 * g] + bsv, acc[mi][ni][4 * g + 1] + bsv);
            o.y = pack_bf16(acc[mi][ni][4 * g + 2] + bsv, acc[mi][ni][4 * g + 3] + bsv);
            *(uint2*)(l + pl * STG_ROWB + (col + 8 * g) * 2) = o;
          }
        }
      }
      __syncthreads();
#pragma unroll
      for (int i = 0; i < 8; ++i) {
        const int r = (t >> 4) + 16 * i, c8 = t & 15;
        const size_t row = (size_t)c * 128 + r;
        const uint4 gv = *(const uint4*)(l + r * STG_ROWB + c8 * 16);
        const uint4 uu = *(const uint4*)(Z + row * 2048 + h * 128 + c8 * 8);
        const uint32_t a[4] = {gv.x, gv.y, gv.z, gv.w}, b[4] = {uu.x, uu.y, uu.z, uu.w};
        uint32_t o[4];
#pragma unroll
        for (int j = 0; j < 4; ++j) o[j] = pack_bf16(bf_lo(a[j]) * bf_lo(b[j]), bf_hi(a[j]) * bf_hi(b[j]));
        *(uint4*)(UV + row * 1024 + h * 128 + c8 * 8) = make_uint4(o[0], o[1], o[2], o[3]);
      }
    }
    __syncthreads();
  }
}

__device__ __forceinline__ void phase_cm_out(const Params& p, int l, int k, Smem& sm) {
  const int tid__ = tid_();
  const float* mod = (const float*)(p.ws + OFF_MOD);
  const int lane = tid__ & 63, w = tid__ >> 6, wr = w >> 1, wc = w & 1;
  gemm_phase(tid__, (const bf16_t*)(p.ws + OFF_BUF2), (const bf16_t*)(p.ws + OFF_WOUTC) + (size_t)k * 1024 * 1024, TT / 128, 8, sm,
    [&](f32x16 (&acc)[2][2], int mt, int nt) {
      const float* g1 = mod + (size_t)(l * 9 + row_batch(mt * 128)) * 6144 + 2048;
#pragma unroll
      for (int mi = 0; mi < 2; ++mi) {
        const int row = mt * 128 + wr * 64 + mi * 32 + (lane & 31);
        float* xr = xrow_ptr(p, row);
#pragma unroll
        for (int ni = 0; ni < 2; ++ni) {
          const int col = nt * 128 + wc * 64 + ni * 32 + 4 * (lane >> 5);
#pragma unroll
          for (int g = 0; g < 4; ++g) {
            float4 xv = *(float4*)(xr + col + 8 * g);
            const float4 gv = *(const float4*)(g1 + col + 8 * g);
            xv.x += gv.x * acc[mi][ni][4 * g]; xv.y += gv.y * acc[mi][ni][4 * g + 1];
            xv.z += gv.z * acc[mi][ni][4 * g + 2]; xv.w += gv.w * acc[mi][ni][4 * g + 3];
            *(float4*)(xr + col + 8 * g) = xv;
          }
        }
      }
    });
}

__device__ __forceinline__ void phase_ssm_in(const Params& p, int k, Smem& sm) {
  const int tid__ = tid_();
  bf16_t* U = (bf16_t*)(p.ws + OFF_BUF2);
  const int lane = tid__ & 63, w = tid__ >> 6, wr = w >> 1, wc = w & 1;
  gemm_phase(tid__, (const bf16_t*)(p.ws + OFF_XN), (const bf16_t*)(p.ws + OFF_WINS) + (size_t)k * 1024 * 1024, TT / 128, 8, sm,
    [&](f32x16 (&acc)[2][2], int mt, int nt) {
#pragma unroll
      for (int mi = 0; mi < 2; ++mi) {
        const int row = mt * 128 + wr * 64 + mi * 32 + (lane & 31);
#pragma unroll
        for (int ni = 0; ni < 2; ++ni) {
          const int col = nt * 128 + wc * 64 + ni * 32 + 4 * (lane >> 5);
#pragma unroll
          for (int g = 0; g < 4; ++g) {
            const int cc = col + 8 * g, grp = cc >> 4, ch = cc & 15;
            uint2 o; o.x = pack_bf16(acc[mi][ni][4 * g], acc[mi][ni][4 * g + 1]); o.y = pack_bf16(acc[mi][ni][4 * g + 2], acc[mi][ni][4 * g + 3]);
            *(uint2*)(U + ((size_t)grp * TT + row) * 16 + ch) = o;
          }
        }
      }
    });
}

constexpr int SCAN_ROWB = 272;
constexpr int SCAN_WAVE_LDS = 32 * SCAN_ROWB;
__device__ __forceinline__ void scan_item(int tid__, const Params& p, int k, int item, unsigned char* lds) {
  const int lane = tid__ & 63;
  const int dir = item & 1, g = (item >> 1) & 63, b = item >> 7;
  const bf16_t* U = (const bf16_t*)(p.ws + OFF_BUF2) + (size_t)g * TT * 16;
  bf16_t* Y = (bf16_t*)(p.ws + OFF_BUF1) + (size_t)dir * TT * 1024 + (size_t)g * TT * 16;
  const int pbase = ((k * 2 + dir) * 64 + g) * 64;
  const float step = expf(p.in[I_LSTEP][(k * 2 + dir) * 64 + g]);
  float ar, ai;
  {
    const float lr = p.in[I_LRE][pbase + lane], li = p.in[I_LIM][pbase + lane];
    const float mag = expf(lr * step);
    ar = mag * cosf(li * step); ai = mag * sinf(li * step);
  }
  bf16x8 bfrag[4];
#pragma unroll
  for (int hb = 0; hb < 2; ++hb) {
    const int pp = hb * 32 + (lane & 31);
    const float lr = p.in[I_LRE][pbase + pp], li = p.in[I_LIM][pbase + pp];
    const float mag = expf(lr * step);
    const float a_r = mag * cosf(li * step), a_i = mag * sinf(li * step);
    const float den = lr * lr + li * li;
    const float cr = ((a_r - 1.0f) * lr + a_i * li) / den;
    const float ci = (a_i * lr - (a_r - 1.0f) * li) / den;
    const float* bre = p.in[I_BRE] + (size_t)(pbase + pp) * 16 + 8 * (lane >> 5);
    const float* bim = p.in[I_BIM] + (size_t)(pbase + pp) * 16 + 8 * (lane >> 5);
    float re[8], im[8];
#pragma unroll
    for (int j = 0; j < 8; ++j) { re[j] = cr * bre[j] - ci * bim[j]; im[j] = cr * bim[j] + ci * bre[j]; }
    uint4 vr, vi;
    vr.x = pack_bf16(re[0], re[1]); vr.y = pack_bf16(re[2], re[3]); vr.z = pack_bf16(re[4], re[5]); vr.w = pack_bf16(re[6], re[7]);
    vi.x = pack_bf16(im[0], im[1]); vi.y = pack_bf16(im[2], im[3]); vi.z = pack_bf16(im[4], im[5]); vi.w = pack_bf16(im[6], im[7]);
    bfrag[hb] = *(bf16x8*)&vr; bfrag[2 + hb] = *(bf16x8*)&vi;
  }
  bf16x8 cfrag[4];
  {
    const int cbase = (((k * 2 + dir) * 64 + g) * 16 + (lane & 15)) * 64;
#pragma unroll
    for (int ks = 0; ks < 4; ++ks) {
      const int p0 = 16 * ks + 4 * (lane >> 4);
      const float4 cr = *(const float4*)(p.in[I_CRE] + cbase + p0), ci = *(const float4*)(p.in[I_CIM] + cbase + p0);
      uint4 v; v.x = pack_bf16(cr.x, -ci.x); v.y = pack_bf16(cr.y, -ci.y); v.z = pack_bf16(cr.z, -ci.z); v.w = pack_bf16(cr.w, -ci.w);
      cfrag[ks] = *(bf16x8*)&v;
    }
  }
  float hr = 0.f, hi = 0.f;
  const int ctx0 = TL + b * 256, lat0 = b * 8192;
  auto chunk_r0 = [&](int ci) -> int {
    int base, len, cc;
    if (ci < 8) { base = ctx0; len = 256; cc = ci; } else { base = lat0; len = 8192; cc = ci - 8; }
    return dir == 0 ? base + cc * 32 : base + len - 32 * (cc + 1);
  };
  const int tau_l = lane & 31;
  uint4 unext;
  {
    const int r0 = chunk_r0(0);
    const int row = dir == 0 ? r0 + tau_l : r0 + 31 - tau_l;
    unext = *(const uint4*)(U + (size_t)row * 16 + 8 * (lane >> 5));
  }
  uint2 ypend[2] = {make_uint2(0u, 0u), make_uint2(0u, 0u)};
  size_t opend[2];
  {
    const int r0 = chunk_r0(0);
#pragma unroll
    for (int nb = 0; nb < 2; ++nb) {
      const int tau = nb * 16 + (lane & 15);
      opend[nb] = (size_t)(dir == 0 ? r0 + tau : r0 + 31 - tau) * 16 + 4 * (lane >> 4);
    }
  }
  for (int ci = 0; ci < 264; ++ci) {
    const int r0 = chunk_r0(ci);
    const uint4 ucur = unext;
    const bf16x8 afrag = *(const bf16x8*)&ucur;
    f32x16 bu[4];
#pragma unroll
    for (int nb = 0; nb < 4; ++nb) {
#pragma unroll
      for (int r = 0; r < 16; ++r) bu[nb][r] = 0.f;
      bu[nb] = __builtin_amdgcn_mfma_f32_32x32x16_bf16(afrag, bfrag[nb], bu[nb], 0, 0, 0);
    }
    __builtin_amdgcn_sched_barrier(0);
    {
      *(uint2*)(Y + opend[0]) = ypend[0];
      *(uint2*)(Y + opend[1]) = ypend[1];
      const int r1 = chunk_r0(ci + 1 < 264 ? ci + 1 : 263);
      const int row = dir == 0 ? r1 + tau_l : r1 + 31 - tau_l;
      unext = *(const uint4*)(U + (size_t)row * 16 + 8 * (lane >> 5));
    }
    __builtin_amdgcn_sched_barrier(0);
#pragma unroll
    for (int r = 0; r < 16; ++r) {
      auto s0 = __builtin_amdgcn_permlane32_swap(__float_as_uint(bu[0][r]), __float_as_uint(bu[1][r]), false, false);
      bu[0][r] = __uint_as_float(s0[0]); bu[1][r] = __uint_as_float(s0[1]);
      auto s1 = __builtin_amdgcn_permlane32_swap(__float_as_uint(bu[2][r]), __float_as_uint(bu[3][r]), false, false);
      bu[2][r] = __uint_as_float(s1[0]); bu[3][r] = __uint_as_float(s1[1]);
    }
    asm volatile("" ::: "memory");
#pragma unroll
    for (int tau = 0; tau < 32; ++tau) {
      const int hb = (tau >> 2) & 1, r = (tau & 3) + 4 * (tau >> 3);
      const float bre = hb ? bu[1][r] : bu[0][r], bim = hb ? bu[3][r] : bu[2][r];
      const float nr = fmaf(ar, hr, fmaf(-ai, hi, bre));
      const float ni = fmaf(ar, hi, fmaf(ai, hr, bim));
      hr = nr; hi = ni;
      *(uint32_t*)(lds + tau * SCAN_ROWB + lane * 4) = pack_bf16(hr, hi);
    }
    asm volatile("s_waitcnt lgkmcnt(0)" ::: "memory");
#pragma unroll
    for (int nb = 0; nb < 2; ++nb) {
      f32x4 y = {0.f, 0.f, 0.f, 0.f};
#pragma unroll
      for (int ks = 0; ks < 4; ++ks) {
        const uint4 hv = *(const uint4*)(lds + (nb * 16 + (lane & 15)) * SCAN_ROWB + ks * 64 + (lane >> 4) * 16);
        y = __builtin_amdgcn_mfma_f32_16x16x32_bf16(cfrag[ks], *(const bf16x8*)&hv, y, 0, 0, 0);
      }
      const int tau = nb * 16 + (lane & 15);
      const int row = dir == 0 ? r0 + tau : r0 + 31 - tau;
      ypend[nb].x = pack_bf16(y[0], y[1]); ypend[nb].y = pack_bf16(y[2], y[3]);
      opend[nb] = (size_t)row * 16 + 4 * (lane >> 4);
    }
    asm volatile("s_waitcnt lgkmcnt(0)" ::: "memory");
  }
  *(uint2*)(Y + opend[0]) = ypend[0];
  *(uint2*)(Y + opend[1]) = ypend[1];
}
__device__ __forceinline__ void phase_scan(const Params& p, int k, Smem& sm) {
  const int tid__ = tid_();
  const int w = tid__ >> 6;
  const int nact = gridDim.x < 256 ? gridDim.x : 256;
  const int ipb = (1024 + nact - 1) / nact;
  unsigned char* lds = (unsigned char*)&sm + (size_t)w * SCAN_WAVE_LDS;
  if ((int)blockIdx.x < nact) {
    for (int s = w; s < ipb; s += 4) {
      const int item = blockIdx.x * ipb + s;
      if (item < 1024) scan_item(tid__, p, k, item, lds);
    }
  }
}

__device__ __forceinline__ void phase_ssm_comb(const Params& p, int k) {
  const int tid__ = tid_();
  const bf16_t* U = (const bf16_t*)(p.ws + OFF_BUF2);
  const bf16_t* YF = (const bf16_t*)(p.ws + OFF_BUF1);
  const bf16_t* YB = YF + (size_t)TT * 1024;
  bf16_t* G = (bf16_t*)(p.ws + OFF_XN);
  const float* dsk = p.in[I_SD] + k * 1024;
  const int nblk = TT / 8;
  for (int rb = blockIdx.x; rb < nblk; rb += gridDim.x) {
#pragma unroll
    for (int it = 0; it < 4; ++it) {
      const int e = it * 256 + tid__;
      const int row = rb * 8 + (e >> 7), g = (e >> 1) & 63, half = e & 1;
      const size_t off = ((size_t)g * TT + row) * 16 + half * 8;
      const uint4 u = *(const uint4*)(U + off), yf = *(const uint4*)(YF + off), yb = *(const uint4*)(YB + off);
      const float4 d0 = *(const float4*)(dsk + g * 16 + half * 8), d1 = *(const float4*)(dsk + g * 16 + half * 8 + 4);
      const uint32_t uw[4] = {u.x, u.y, u.z, u.w}, fw[4] = {yf.x, yf.y, yf.z, yf.w}, bw[4] = {yb.x, yb.y, yb.z, yb.w};
      const float dd[8] = {d0.x, d0.y, d0.z, d0.w, d1.x, d1.y, d1.z, d1.w};
      uint32_t ow[4];
#pragma unroll
      for (int i = 0; i < 4; ++i) {
        const float a = gelu_tanh(bf_lo(fw[i]) + bf_lo(bw[i]) + dd[2 * i] * bf_lo(uw[i]));
        const float c = gelu_tanh(bf_hi(fw[i]) + bf_hi(bw[i]) + dd[2 * i + 1] * bf_hi(uw[i]));
        ow[i] = pack_bf16(a, c);
      }
      *(uint4*)(G + (size_t)row * 1024 + g * 16 + half * 8) = make_uint4(ow[0], ow[1], ow[2], ow[3]);
    }
  }
}

__device__ __forceinline__ void phase_ssm_out(const Params& p, int l, int k, int M, Smem& sm) {
  const int tid__ = tid_();
  const float* mod = (const float*)(p.ws + OFF_MOD);
  const int lane = tid__ & 63, w = tid__ >> 6, wr = w >> 1, wc = w & 1;
  gemm_phase(tid__, (const bf16_t*)(p.ws + OFF_XN), (const bf16_t*)(p.ws + OFF_WOUTS) + (size_t)k * 2048 * 1024, M / 128, 16, sm,
    [&](f32x16 (&acc)[2][2], int mt, int nt) {
      const float* g1 = mod + (size_t)(l * 9 + row_batch(mt * 128)) * 6144 + 2048;
#pragma unroll
      for (int mi = 0; mi < 2; ++mi) {
        const int row = mt * 128 + wr * 64 + mi * 32 + (lane & 31);
        float* xr = xrow_ptr(p, row);
        const int col = (nt * 2 + wc) * 32 + 4 * (lane >> 5);
#pragma unroll
        for (int g = 0; g < 4; ++g) {
          float4 xv = *(float4*)(xr + col + 8 * g);
          const float4 gv = *(const float4*)(g1 + col + 8 * g);
          xv.x += gv.x * acc[mi][0][4 * g] * sigmoidf_(acc[mi][1][4 * g]);
          xv.y += gv.y * acc[mi][0][4 * g + 1] * sigmoidf_(acc[mi][1][4 * g + 1]);
          xv.z += gv.z * acc[mi][0][4 * g + 2] * sigmoidf_(acc[mi][1][4 * g + 2]);
          xv.w += gv.w * acc[mi][0][4 * g + 3] * sigmoidf_(acc[mi][1][4 * g + 3]);
          *(float4*)(xr + col + 8 * g) = xv;
        }
      }
    });
}

__device__ __forceinline__ void phase_peer_score(const Params& p, int l, int M, Smem& sm) {
  const int tid__ = tid_();
  uint32_t* topk = (uint32_t*)(p.ws + OFF_TOPK);
  const int lane = tid__ & 63, w = tid__ >> 6, wr = w >> 1, wc = w & 1;
  uint32_t* ks = (uint32_t*)&sm;
  gemm_phase(tid__, (const bf16_t*)(p.ws + OFF_XN), (const bf16_t*)(p.ws + OFF_WEFF) + (size_t)l * 2048 * 1024, M / 128, 16, sm,
    [&](f32x16 (&acc)[2][2], int mt, int nt) {
#pragma unroll
      for (int mi = 0; mi < 2; ++mi) {
        uint32_t va[16], vb[16];
#pragma unroll
        for (int r = 0; r < 16; ++r) {
          const int c0 = wc * 64 + 8 * (r >> 2) + 4 * (lane >> 5) + (r & 3);
          va[r] = (ord_key(acc[mi][0][r]) & ~0x7fu) | (uint32_t)(127 - c0);
          vb[r] = (ord_key(acc[mi][1][r]) & ~0x7fu) | (uint32_t)(127 - (c0 + 32));
        }
        sort16_desc(va); __builtin_amdgcn_sched_barrier(0); sort16_desc(vb); __builtin_amdgcn_sched_barrier(0);
        uint32_t m[16];
#pragma unroll
        for (int i = 0; i < 16; ++i) m[i] = max(va[i], vb[15 - i]);
        merge16_desc(m);
        uint32_t q[16];
#pragma unroll
        for (int i = 0; i < 16; ++i) q[i] = __shfl_xor(m[15 - i], 32);
#pragma unroll
        for (int i = 0; i < 16; ++i) m[i] = max(m[i], q[i]);
        merge16_desc(m);
        if (lane < 32) {
          uint4* dst = (uint4*)(ks + ((((wr * 2 + mi) * 2 + wc) * 32 + lane) * 16));
          dst[0] = make_uint4(m[0], m[1], m[2], m[3]); dst[1] = make_uint4(m[4], m[5], m[6], m[7]);
          dst[2] = make_uint4(m[8], m[9], m[10], m[11]); dst[3] = make_uint4(m[12], m[13], m[14], m[15]);
        }
        __builtin_amdgcn_sched_barrier(0);
      }
      __syncthreads();
      {
        const int mi = wc, rl = lane & 31;
        const uint4* la = (const uint4*)(ks + ((((wr * 2 + mi) * 2 + 0) * 32 + rl) * 16));
        const uint4* lb = (const uint4*)(ks + ((((wr * 2 + mi) * 2 + 1) * 32 + rl) * 16));
        uint32_t a[16], b[16];
#pragma unroll
        for (int i = 0; i < 4; ++i) {
          const uint4 x = la[i], y = lb[i];
          a[4 * i] = x.x; a[4 * i + 1] = x.y; a[4 * i + 2] = x.z; a[4 * i + 3] = x.w;
          b[4 * i] = y.x; b[4 * i + 1] = y.y; b[4 * i + 2] = y.z; b[4 * i + 3] = y.w;
        }
        uint32_t m[16];
#pragma unroll
        for (int i = 0; i < 16; ++i) m[i] = max(a[i], b[15 - i]);
        merge16_desc(m);
        if (lane < 32) {
          const int row = mt * 128 + wr * 64 + mi * 32 + rl;
          uint4* dst = (uint4*)(topk + (size_t)row * 256 + nt * 16);
          dst[0] = make_uint4(m[0], m[1], m[2], m[3]); dst[1] = make_uint4(m[4], m[5], m[6], m[7]);
          dst[2] = make_uint4(m[8], m[9], m[10], m[11]); dst[3] = make_uint4(m[12], m[13], m[14], m[15]);
        }
      }
    });
}

typedef float f32x2 __attribute__((ext_vector_type(2)));
typedef _Float16 f16x2 __attribute__((ext_vector_type(2)));
__device__ __forceinline__ void fp8x16_to_f32(const uint4& r, float (&f)[16]) {
  const uint32_t w[4] = {r.x, r.y, r.z, r.w};
#pragma unroll
  for (int j = 0; j < 4; ++j) {
    const f32x2 lo = __builtin_amdgcn_cvt_pk_f32_fp8((int)w[j], false), hi = __builtin_amdgcn_cvt_pk_f32_fp8((int)w[j], true);
    f[4 * j] = lo.x; f[4 * j + 1] = lo.y; f[4 * j + 2] = hi.x; f[4 * j + 3] = hi.y;
  }
}
__device__ __forceinline__ void peer_load4(const uint8_t* PU, const uint8_t* PV, uint32_t idsr, int bl, int lane, uint4 (&U)[4], uint4 (&V)[4]) {
#pragma unroll
  for (int e = 0; e < 4; ++e) {
    const uint32_t id = __builtin_amdgcn_readlane(idsr, bl + e);
    U[e] = ((const uint4*)(PU + (size_t)id * 1024))[lane];
    V[e] = ((const uint4*)(PV + (size_t)id * 1024))[lane];
  }
}
__device__ __forceinline__ void peer_comp4(const uint4 (&U)[4], const uint4 (&V)[4], const float (&hf)[16], float gwr, int bl, int lane, float (&acc)[16]) {
  float pd[4];
#pragma unroll
  for (int e = 0; e < 4; ++e) {
    float uf[16];
    fp8x16_to_f32(U[e], uf);
    float s0 = 0.f, s1 = 0.f;
#pragma unroll
    for (int i = 0; i < 8; ++i) { s0 = fmaf(hf[2 * i], uf[2 * i], s0); s1 = fmaf(hf[2 * i + 1], uf[2 * i + 1], s1); }
    pd[e] = s0 + s1;
  }
  float r2[2], r1;
#pragma unroll
  for (int j = 0; j < 2; ++j) {
    const float keep = (lane & 1) ? pd[2 * j + 1] : pd[2 * j], send = (lane & 1) ? pd[2 * j] : pd[2 * j + 1];
    r2[j] = keep + __shfl_xor(send, 1);
  }
  {
    const float keep = (lane & 2) ? r2[1] : r2[0], send = (lane & 2) ? r2[0] : r2[1];
    r1 = keep + __shfl_xor(send, 2);
  }
  r1 += __shfl_xor(r1, 4); r1 += __shfl_xor(r1, 8); r1 += __shfl_xor(r1, 16); r1 += __shfl_xor(r1, 32);
  const float wv = gelu_tanh(r1 * (1.0f / 32.0f)) * __shfl(gwr, bl + (lane & 3)) * (1.0f / 8.0f);
#pragma unroll
  for (int e = 0; e < 4; ++e) {
    const float we = __uint_as_float(__builtin_amdgcn_readlane(__float_as_uint(wv), e));
    float vf[16];
    fp8x16_to_f32(V[e], vf);
#pragma unroll
    for (int i = 0; i < 16; ++i) acc[i] = fmaf(we, vf[i], acc[i]);
  }
}
__device__ __forceinline__ void phase_peer_gather(const Params& p, int l, int M) {
  const int tid__ = tid_();
  const int lane = tid__ & 63, gw = blockIdx.x * 4 + (tid__ >> 6), nw = gridDim.x * 4;
  const uint32_t* topk = (const uint32_t*)(p.ws + OFF_TOPK);
  bf16_t* xn = (bf16_t*)(p.ws + OFF_XN);
  const uint8_t* PU = (const uint8_t*)(p.ws + OFF_PU) + (size_t)l * 16384 * 1024;
  const uint8_t* PV = (const uint8_t*)(p.ws + OFF_PV) + (size_t)l * 16384 * 1024;
  const float* mod = (const float*)(p.ws + OFF_MOD);
  int ic, jc; const bool valid = lane < 50;
  {
    const int c = lane;
    if (c < 16) { ic = 0; jc = c; } else if (c < 24) { ic = 1; jc = c - 16; } else if (c < 29) { ic = 2; jc = c - 24; }
    else if (c < 33) { ic = 3; jc = c - 29; } else if (c < 36) { ic = 4; jc = c - 33; }
    else if (c < 42) { ic = 5 + ((c - 36) >> 1); jc = (c - 36) & 1; } else { ic = 8 + (c - 42); jc = 0; }
    if (!valid) { ic = 0; jc = 0; }
  }
  for (int row = gw; row < M; row += nw) {
    const uint32_t* tk = topk + (size_t)row * 256;
    uint32_t ids0 = 0, ids1 = 0; float gw0 = 0.f, gw1 = 0.f;
#pragma unroll 1
    for (int h = 0; h < 8; ++h) {
      const uint32_t K1 = tk[(2 * h) * 16 + (lane & 15)], K2 = tk[(2 * h + 1) * 16 + (lane & 15)];
      const float s1 = ord_dec(__shfl(K1, ic) & ~0x7fu), s2 = ord_dec(__shfl(K2, jc) & ~0x7fu);
      const uint32_t flat = (uint32_t)(ic * 16 + jc);
      const uint32_t key = valid ? ((ord_key(s1 + s2) & ~0xffu) | (255u - flat)) : 0u;
      int rank = 0;
#pragma unroll
      for (int c = 0; c < 50; ++c) {
        const uint32_t kk = __builtin_amdgcn_readlane(key, c);
        rank += (kk > key) ? 1 : 0;
      }
      const uint32_t fsorted = __builtin_amdgcn_ds_permute(rank * 4, flat);
      const uint32_t fl = __shfl(fsorted, lane & 15);
      const uint32_t k1 = __shfl(K1, (int)(fl >> 4)), k2 = __shfl(K2, (int)(fl & 15));
      const float sc = ord_dec(k1 & ~0x7fu) + ord_dec(k2 & ~0x7fu);
      const uint32_t id = (127u - (k1 & 127u)) * 128u + (127u - (k2 & 127u));
      const float mx = __shfl(sc, 0);
      const float e = __expf(sc - mx);
      float se = e;
      se += __shfl_xor(se, 1); se += __shfl_xor(se, 2); se += __shfl_xor(se, 4); se += __shfl_xor(se, 8);
      const float gsm = e / se;
      if ((lane >> 4) == (h & 3)) { if (h < 4) { ids0 = id; gw0 = gsm; } else { ids1 = id; gw1 = gsm; } }
    }
    float hf[16];
    {
      const uint4 h0 = ((const uint4*)(xn + (size_t)row * DM))[2 * lane], h1 = ((const uint4*)(xn + (size_t)row * DM))[2 * lane + 1];
      const uint32_t hw[8] = {h0.x, h0.y, h0.z, h0.w, h1.x, h1.y, h1.z, h1.w};
#pragma unroll
      for (int i = 0; i < 8; ++i) { hf[2 * i] = bf_lo(hw[i]); hf[2 * i + 1] = bf_hi(hw[i]); }
    }
    float acc[16];
#pragma unroll
    for (int i = 0; i < 16; ++i) acc[i] = 0.f;
    uint4 U0[4], V0[4], U1[4], V1[4];
#if (DUP_MASK >> 8) & 1
    gw0 *= 0.5f; gw1 *= 0.5f;
#pragma unroll 1
    for (int rep = 0; rep < 2; ++rep) {
#endif
    peer_load4(PU, PV, ids0, 0, lane, U0, V0);
#pragma unroll 1
    for (int g2 = 0; g2 < 16; ++g2) {
      const int h = g2 >> 1, bl = (h & 3) * 16 + (g2 & 1) * 8;
      const uint32_t idsr = h < 4 ? ids0 : ids1;
      const float gwr = h < 4 ? gw0 : gw1;
      peer_load4(PU, PV, idsr, bl + 4, lane, U1, V1);
      peer_comp4(U0, V0, hf, gwr, bl, lane, acc);
      if (g2 < 15) {
        const int hn = (g2 + 1) >> 1, bn = (hn & 3) * 16 + ((g2 + 1) & 1) * 8;
        const uint32_t idn = hn < 4 ? ids0 : ids1;
        peer_load4(PU, PV, idn, bn, lane, U0, V0);
      }
      peer_comp4(U1, V1, hf, gwr, bl + 4, lane, acc);
    }
#if (DUP_MASK >> 8) & 1
    }
#endif
    float x[16], g2v[16];
    float* xr = xrow_ptr(p, row);
    load_row16(xr, lane, x);
    const int b = row_batch(row);
    load_row16(mod + (size_t)(l * 9 + b) * 6144 + 5120, lane, g2v);
#pragma unroll
    for (int i = 0; i < 16; ++i) x[i] += g2v[i] * acc[i];
    if (l < 3) {
      store_row16(xr, lane, x);
      const float* m = mod + (size_t)((l + 1) * 9 + b) * 6144;
      norm_mod_store(x, p.in[I_N1G] + (l + 1) * 1024, m, m + 1024, xn + (size_t)row * DM, lane);
    } else {
      float ss = 0.f;
#pragma unroll
      for (int i = 0; i < 16; ++i) ss += x[i] * x[i];
      ss = wave_sum(ss);
      const float rstd = rsqrtf(ss * (1.0f / 1024.0f) + 1e-6f);
      float fg[16];
      load_row16(p.in[I_FG], lane, fg);
#pragma unroll
      for (int i = 0; i < 16; ++i) x[i] = x[i] * rstd * fg[i];
      store_row16(xr, lane, x);
    }
  }
}


constexpr size_t OFF_PD  = OFF_BUF1;
constexpr size_t OFF_IDS = OFF_BUF2;
constexpr size_t OFF_GW  = OFF_IDS + (size_t)TT * 128 * 2;
constexpr size_t OFF_WW  = OFF_GW + (size_t)TT * 128 * 4;
static_assert(OFF_WW + (size_t)TT * 128 * 4 <= OFF_TOPK, "PEER scratch overflows BUF2");

template <int CTRL> __device__ __forceinline__ float dpp_f(float v) {
  return __uint_as_float((uint32_t)__builtin_amdgcn_update_dpp(0, (int)__float_as_uint(v), CTRL, 0xf, 0xf, true));
}

template <int CTRL> __device__ __forceinline__ uint32_t dpp_u(uint32_t v) {
  return (uint32_t)__builtin_amdgcn_update_dpp(0, (int)v, CTRL, 0xf, 0xf, true);
}
__device__ __forceinline__ uint32_t xor_lane(uint32_t x, int d, int lane) {
  switch (d) {
    case 1: return dpp_u<0xB1>(x);
    case 2: return dpp_u<0x4E>(x);
    case 4: return (uint32_t)__builtin_amdgcn_ds_swizzle((int)x, (4 << 10) | 0x1f);
    case 8: return (uint32_t)__builtin_amdgcn_ds_swizzle((int)x, (8 << 10) | 0x1f);
    case 16: return (uint32_t)__builtin_amdgcn_ds_swizzle((int)x, (16 << 10) | 0x1f);
    default: {
      auto r = __builtin_amdgcn_permlane32_swap(x, x, false, false);
      return lane < 32 ? r[1] : r[0];
    }
  }
}
__device__ __forceinline__ float xor_lane_f(float x, int d, int lane) { return __uint_as_float(xor_lane(__float_as_uint(x), d, lane)); }
__device__ __forceinline__ void phase_peer_combine(const Params& p, int M) {
  const int tid__ = tid_();
  const int lane = tid__ & 63, gw = blockIdx.x * 4 + (tid__ >> 6), nw = gridDim.x * 4;
  const uint32_t* topk = (const uint32_t*)(p.ws + OFF_TOPK);
  uint16_t* idsT = (uint16_t*)(p.ws + OFF_IDS);
  float* gwT = (float*)(p.ws + OFF_GW);
  int ic, jc; const bool valid = lane < 50;
  {
    const int c = lane;
    if (c < 16) { ic = 0; jc = c; } else if (c < 24) { ic = 1; jc = c - 16; } else if (c < 29) { ic = 2; jc = c - 24; }
    else if (c < 33) { ic = 3; jc = c - 29; } else if (c < 36) { ic = 4; jc = c - 33; }
    else if (c < 42) { ic = 5 + ((c - 36) >> 1); jc = (c - 36) & 1; } else { ic = 8 + (c - 42); jc = 0; }
    if (!valid) { ic = 0; jc = 0; }
  }
  const uint32_t flat = (uint32_t)(ic * 16 + jc);
  uint32_t KN[16];
  if (gw < M) {
#pragma unroll
    for (int i = 0; i < 16; ++i) KN[i] = topk[(size_t)gw * 256 + i * 16 + (lane & 15)];
  }
  for (int row = gw; row < M; row += nw) {
    uint32_t KC[16];
#pragma unroll
    for (int i = 0; i < 16; ++i) KC[i] = KN[i];
#pragma unroll
    for (int hg = 0; hg < 2; ++hg) {
      uint32_t K1[4], K2[4], key[4];
#pragma unroll
      for (int hh = 0; hh < 4; ++hh) {
        const int h = hg * 4 + hh;
        K1[hh] = KC[2 * h]; K2[hh] = KC[2 * h + 1];
      }
#pragma unroll
      for (int hh = 0; hh < 4; ++hh) {
        const float s1 = ord_dec(__shfl(K1[hh], ic) & ~0x7fu), s2 = ord_dec(__shfl(K2[hh], jc) & ~0x7fu);
        key[hh] = valid ? ((ord_key(s1 + s2) & ~0xffu) | (255u - flat)) : 0u;
      }
#pragma unroll
      for (int k = 2; k <= 64; k <<= 1) {
#pragma unroll
        for (int j = k >> 1; j > 0; j >>= 1) {
          const bool desc = (k == 64) ? true : ((lane & k) == 0);
          const bool lower = (lane & j) == 0;
          uint32_t pk[4];
#pragma unroll
          for (int hh = 0; hh < 4; ++hh) pk[hh] = xor_lane(key[hh], j, lane);
#pragma unroll
          for (int hh = 0; hh < 4; ++hh) {
            const uint32_t mx = max(key[hh], pk[hh]), mn = min(key[hh], pk[hh]);
            key[hh] = (desc == lower) ? mx : mn;
          }
        }
      }
      uint32_t k1[4], k2[4];
#pragma unroll
      for (int hh = 0; hh < 4; ++hh) {
        const uint32_t fl = 255u - (key[hh] & 255u);
        k1[hh] = __shfl(K1[hh], (int)(fl >> 4)); k2[hh] = __shfl(K2[hh], (int)(fl & 15));
      }
      float e[4], se[4];
#pragma unroll
      for (int hh = 0; hh < 4; ++hh) {
        const float sc = ord_dec(k1[hh] & ~0x7fu) + ord_dec(k2[hh] & ~0x7fu);
        const float mx = __uint_as_float(__builtin_amdgcn_readlane(__float_as_uint(sc), 0));
        e[hh] = __expf(sc - mx); se[hh] = e[hh];
      }
#pragma unroll
      for (int d = 1; d <= 8; d <<= 1) {
        float t4[4];
#pragma unroll
        for (int hh = 0; hh < 4; ++hh) t4[hh] = xor_lane_f(se[hh], d, lane);
#pragma unroll
        for (int hh = 0; hh < 4; ++hh) se[hh] += t4[hh];
      }
      if (lane < 16) {
#pragma unroll
        for (int hh = 0; hh < 4; ++hh) {
          const int h = hg * 4 + hh, k = lane, pos = (k & 7) * 16 + 2 * h + (k >> 3);
          const uint32_t id = (127u - (k1[hh] & 127u)) * 128u + (127u - (k2[hh] & 127u));
          idsT[(size_t)row * 128 + pos] = (uint16_t)id;
          gwT[(size_t)row * 128 + pos] = e[hh] / se[hh];
        }
      }
      if (hg == 0) {
        __builtin_amdgcn_sched_barrier(0);
        const uint32_t* tn = topk + (size_t)(row + nw < M ? row + nw : row) * 256 + (lane & 15);
#pragma unroll
        for (int i = 0; i < 16; ++i) KN[i] = tn[i * 16];
        __builtin_amdgcn_sched_barrier(0);
      }
    }
  }
}

typedef uint32_t u32x4v __attribute__((ext_vector_type(4)));
__device__ __forceinline__ uint4 ld_nt16(const void* p) { const u32x4v v = __builtin_nontemporal_load((const u32x4v*)p); return make_uint4(v.x, v.y, v.z, v.w); }
__device__ __forceinline__ float2 ld_nt8(const void* p) { const f32x2 v = __builtin_nontemporal_load((const f32x2*)p); return make_float2(v.x, v.y); }
__device__ __forceinline__ void st_nt8(void* p, float2 v) { const f32x2 t = {v.x, v.y}; __builtin_nontemporal_store(t, (f32x2*)p); }
__device__ __forceinline__ uint32_t peer_id16(const uint4& i0, const uint4& i1, int i) {
  const uint32_t iw[8] = {i0.x, i0.y, i0.z, i0.w, i1.x, i1.y, i1.z, i1.w};
  return (i & 1) ? (iw[i >> 1] >> 16) : (iw[i >> 1] & 0xffffu);
}
__device__ __forceinline__ void phase_peer_dots(const Params& p, int l, int M) {
  const int tid__ = tid_();
  const int lane = tid__ & 63, grp = lane >> 3, j = lane & 7;
  const int s = blockIdx.x & 7, worker = (blockIdx.x >> 3) * 4 + (tid__ >> 6), nworker = (gridDim.x >> 3) * 4;
  const uint16_t* idsT = (const uint16_t*)(p.ws + OFF_IDS) + grp * 16;
  const bf16_t* xn = (const bf16_t*)(p.ws + OFF_XN) + 128 * s + 16 * j;
  bf16_t* pd = (bf16_t*)(p.ws + OFF_PD) + (size_t)s * 128 + grp * 16 + 8 * (j & 1) + 4 * ((j >> 1) & 1) + 2 * (j >> 2);
  const uint8_t* PU = (const uint8_t*)(p.ws + OFF_PU) + ((size_t)l * 8 + s) * 16384 * 128 + 16 * j;
  const int last = M - 1;
  int row = worker;
  uint4 ia0 = *(const uint4*)(idsT + (size_t)row * 128), ia1 = *(const uint4*)(idsT + (size_t)row * 128 + 8);
  uint4 U[16];
#pragma unroll
  for (int i = 0; i < 16; ++i) U[i] = *(const uint4*)(PU + (size_t)peer_id16(ia0, ia1, i) * 128);
  uint4 h0 = *(const uint4*)(xn + (size_t)row * DM), h1 = *(const uint4*)(xn + (size_t)row * DM + 8);
  {
    const int rn = min(row + nworker, last);
    ia0 = *(const uint4*)(idsT + (size_t)rn * 128); ia1 = *(const uint4*)(idsT + (size_t)rn * 128 + 8);
  }
  for (; row < M; row += nworker) {
    const int rn = min(row + nworker, last), rnn = min(row + 2 * nworker, last);
    const uint4 ib0 = *(const uint4*)(idsT + (size_t)rnn * 128), ib1 = *(const uint4*)(idsT + (size_t)rnn * 128 + 8);
    const uint4 hn0 = *(const uint4*)(xn + (size_t)rn * DM), hn1 = *(const uint4*)(xn + (size_t)rn * DM + 8);
    f16x2 hh[8];
    {
      const uint32_t hw[8] = {h0.x, h0.y, h0.z, h0.w, h1.x, h1.y, h1.z, h1.w};
#pragma unroll
      for (int c = 0; c < 8; ++c) { hh[c].x = (_Float16)bf_lo(hw[c]); hh[c].y = (_Float16)bf_hi(hw[c]); }
    }
    float pp[16];
#pragma unroll
    for (int i = 0; i < 16; ++i) {
      const uint4 ur = U[i];
      U[i] = *(const uint4*)(PU + (size_t)peer_id16(ia0, ia1, i) * 128);
      const int uw[4] = {(int)ur.x, (int)ur.y, (int)ur.z, (int)ur.w};
      float sv = 0.f;
#pragma unroll
      for (int c = 0; c < 4; ++c) {
        sv = __builtin_amdgcn_fdot2(__builtin_bit_cast(f16x2, __builtin_amdgcn_cvt_scalef32_pk_f16_fp8(uw[c], 1.0f, false)), hh[2 * c], sv, false);
        sv = __builtin_amdgcn_fdot2(__builtin_bit_cast(f16x2, __builtin_amdgcn_cvt_scalef32_pk_f16_fp8(uw[c], 1.0f, true)), hh[2 * c + 1], sv, false);
      }
      pp[i] = sv;
      if ((i & 3) == 3) __builtin_amdgcn_sched_barrier(0);
    }
    float q[8], r[4], t2[2];
#pragma unroll
    for (int mm = 0; mm < 8; ++mm) {
      const float keep = (j & 1) ? pp[mm + 8] : pp[mm], send = (j & 1) ? pp[mm] : pp[mm + 8];
      q[mm] = keep + dpp_f<0xB1>(send);
    }
#pragma unroll
    for (int mm = 0; mm < 4; ++mm) {
      const float keep = (j & 2) ? q[mm + 4] : q[mm], send = (j & 2) ? q[mm] : q[mm + 4];
      r[mm] = keep + dpp_f<0x4E>(send);
    }
#pragma unroll
    for (int mm = 0; mm < 2; ++mm) {
      const float keep = (j & 4) ? r[mm + 2] : r[mm], send = (j & 4) ? r[mm] : r[mm + 2];
      t2[mm] = keep + __shfl_xor(send, 4);
    }
    __builtin_nontemporal_store(pack_bf16(t2[0], t2[1]), (uint32_t*)(pd + (size_t)row * 1024));
    ia0 = ib0; ia1 = ib1; h0 = hn0; h1 = hn1;
  }
}

__device__ __forceinline__ void phase_peer_weights(const Params& p, int M) {
  const int tid__ = tid_();
  const int lane = tid__ & 63, gw = blockIdx.x * 4 + (tid__ >> 6), nw = gridDim.x * 4;
  const bf16_t* pd = (const bf16_t*)(p.ws + OFF_PD) + 2 * lane;
  const float* gwT = (const float*)(p.ws + OFF_GW) + 2 * lane;
  _Float16* ww = (_Float16*)(p.ws + OFF_WW) + 2 * lane;
  if (gw >= M) return;
  uint32_t vn[8]; float2 gn;
#pragma unroll
  for (int s = 0; s < 8; ++s) vn[s] = *(const uint32_t*)(pd + ((size_t)gw * 8 + s) * 128);
  gn = *(const float2*)(gwT + (size_t)gw * 128);
  f16x2 pw = {(_Float16)0.f, (_Float16)0.f};
  int prow = gw;
  for (int row = gw; row < M; row += nw) {
    float d0 = 0.f, d1 = 0.f;
#pragma unroll
    for (int s = 0; s < 8; ++s) { d0 += bf_lo(vn[s]); d1 += bf_hi(vn[s]); }
    const float2 g = gn;
    __builtin_amdgcn_sched_barrier(0);
    {
      *(f16x2*)(ww + (size_t)prow * 128) = pw;
      const int rn = row + nw < M ? row + nw : row;
#pragma unroll
      for (int s = 0; s < 8; ++s) vn[s] = *(const uint32_t*)(pd + ((size_t)rn * 8 + s) * 128);
      gn = *(const float2*)(gwT + (size_t)rn * 128);
    }
    __builtin_amdgcn_sched_barrier(0);
    pw.x = (_Float16)(gelu_tanh(d0 * (1.0f / 32.0f)) * g.x * 32.0f);
    pw.y = (_Float16)(gelu_tanh(d1 * (1.0f / 32.0f)) * g.y * 32.0f);
    prow = row;
  }
  *(f16x2*)(ww + (size_t)prow * 128) = pw;
}

struct PeerMetaB { uint4 w0, w1; float2 x; };
__device__ __forceinline__ void phase_peer_values(const Params& p, int l, int M, bool dry) {
  const int tid__ = tid_();
  const int lane = tid__ & 63, grp = lane >> 3, j = lane & 7;
  const int s = blockIdx.x & 7, worker = (blockIdx.x >> 3) * 4 + (tid__ >> 6), nworker = (gridDim.x >> 3) * 4;
  const uint16_t* idsT = (const uint16_t*)(p.ws + OFF_IDS) + grp * 16;
  const _Float16* ww = (const _Float16*)(p.ws + OFF_WW) + grp * 16;
  const int col = 128 * s + 16 * j + 8 * ((lane >> 3) & 1) + 4 * ((lane >> 4) & 1) + 2 * ((lane >> 5) & 1);
  const float* mod = (const float*)(p.ws + OFF_MOD) + (size_t)l * 9 * 6144 + 5120 + col;
  const uint8_t* PV = (const uint8_t*)(p.ws + OFF_PV) + ((size_t)l * 8 + s) * 16384 * 128 + 16 * j;
  auto meta = [&](int r_) {
    PeerMetaB m;
    m.w0 = *(const uint4*)(ww + (size_t)r_ * 128); m.w1 = *(const uint4*)(ww + (size_t)r_ * 128 + 8);
    m.x = *(const float2*)(xrow_ptr(p, r_) + col);
    return m;
  };
  const int last = M - 1;
  int row = worker;
  uint4 ia0 = *(const uint4*)(idsT + (size_t)row * 128), ia1 = *(const uint4*)(idsT + (size_t)row * 128 + 8);
  uint4 V[16];
#pragma unroll
  for (int i = 0; i < 16; ++i) V[i] = *(const uint4*)(PV + (size_t)peer_id16(ia0, ia1, i) * 128);
  PeerMetaB m = meta(row);
  {
    const int rn = min(row + nworker, last);
    ia0 = *(const uint4*)(idsT + (size_t)rn * 128); ia1 = *(const uint4*)(idsT + (size_t)rn * 128 + 8);
  }
  int gb = -1; float2 g2v = make_float2(0.f, 0.f);
  for (; row < M; row += nworker) {
    const int rn = min(row + nworker, last), rnn = min(row + 2 * nworker, last);
    const uint4 ib0 = *(const uint4*)(idsT + (size_t)rnn * 128), ib1 = *(const uint4*)(idsT + (size_t)rnn * 128 + 8);
    const PeerMetaB mn = meta(rn);
    const int b = row_batch(row);
    if (b != gb) { gb = b; g2v = *(const float2*)(mod + (size_t)b * 6144); }
    const uint32_t wp[8] = {m.w0.x, m.w0.y, m.w0.z, m.w0.w, m.w1.x, m.w1.y, m.w1.z, m.w1.w};
    f16x2 acc2[8];
#pragma unroll
    for (int c = 0; c < 8; ++c) acc2[c] = (f16x2){(_Float16)0.f, (_Float16)0.f};
#pragma unroll
    for (int i = 0; i < 16; ++i) {
      const uint4 vr = V[i];
      V[i] = *(const uint4*)(PV + (size_t)peer_id16(ia0, ia1, i) * 128);
      const int vw[4] = {(int)vr.x, (int)vr.y, (int)vr.z, (int)vr.w};
      const f16x2 wpair = __builtin_bit_cast(f16x2, wp[i >> 1]);
      const _Float16 wh = (i & 1) ? wpair.y : wpair.x;
      const f16x2 w2 = {wh, wh};
#pragma unroll
      for (int c = 0; c < 4; ++c) {
        const f16x2 va = __builtin_bit_cast(f16x2, __builtin_amdgcn_cvt_scalef32_pk_f16_fp8(vw[c], 1.0f, false));
        const f16x2 vb = __builtin_bit_cast(f16x2, __builtin_amdgcn_cvt_scalef32_pk_f16_fp8(vw[c], 1.0f, true));
        acc2[2 * c] = __builtin_elementwise_fma(w2, va, acc2[2 * c]);
        acc2[2 * c + 1] = __builtin_elementwise_fma(w2, vb, acc2[2 * c + 1]);
      }
      if ((i & 3) == 3) __builtin_amdgcn_sched_barrier(0);
    }
    float acc[16];
#pragma unroll
    for (int c = 0; c < 8; ++c) { acc[2 * c] = (float)acc2[c].x * (1.0f / 256.0f); acc[2 * c + 1] = (float)acc2[c].y * (1.0f / 256.0f); }
    float q[8], r[4], t2[2];
#pragma unroll
    for (int mm = 0; mm < 8; ++mm) {
      const float keep = (lane & 8) ? acc[mm + 8] : acc[mm], send = (lane & 8) ? acc[mm] : acc[mm + 8];
      q[mm] = keep + dpp_f<0x128>(send);
    }
#pragma unroll
    for (int mm = 0; mm < 4; ++mm) {
      const float keep = (lane & 16) ? q[mm + 4] : q[mm], send = (lane & 16) ? q[mm] : q[mm + 4];
      r[mm] = keep + __shfl_xor(send, 16);
    }
#pragma unroll
    for (int mm = 0; mm < 2; ++mm) {
      const float keep = (lane & 32) ? r[mm + 2] : r[mm], send = (lane & 32) ? r[mm] : r[mm + 2];
      t2[mm] = keep + __shfl_xor(send, 32);
    }
    float* xr = dry ? (float*)(p.ws + OFF_PD) + (size_t)row * 1024 + col : xrow_ptr(p, row) + col;
    st_nt8(xr, make_float2(m.x.x + g2v.x * t2[0], m.x.y + g2v.y * t2[1]));
    ia0 = ib0; ia1 = ib1; m = mn;
  }
}

__device__ __forceinline__ void phase_next_norm(const Params& p, int l, int M) {
  const int tid__ = tid_();
  const int lane = tid__ & 63, gw = blockIdx.x * 4 + (tid__ >> 6), nw = gridDim.x * 4;
  const float* mod = (const float*)(p.ws + OFF_MOD);
  bf16_t* xn = (bf16_t*)(p.ws + OFF_XN);
  if (l < 3) {
    row_norm_pass(p, tid__, M, p.in[I_N1G] + (l + 1) * 1024, mod + (size_t)(l + 1) * 9 * 6144, 0, 1024);
    return;
  }
  for (int row = gw; row < M; row += nw) {
    float x[16];
    float* xr = xrow_ptr(p, row);
    load_row16(xr, lane, x);
    {
      float ss = 0.f;
#pragma unroll
      for (int i = 0; i < 16; ++i) ss += x[i] * x[i];
      ss = wave_sum(ss);
      const float rstd = rsqrtf(ss * (1.0f / 1024.0f) + 1e-6f);
      float fg[16];
      load_row16(p.in[I_FG], lane, fg);
#pragma unroll
      for (int i = 0; i < 16; ++i) x[i] = x[i] * rstd * fg[i];
      store_row16(xr, lane, x);
    }
  }
}


constexpr size_t OFF_BAR = OFF_HN8;
__device__ __forceinline__ void fast_grid_barrier(unsigned* bar, unsigned epoch, int tid) {
  asm volatile("s_waitcnt vmcnt(0)" ::: "memory");
  __syncthreads();
  if (tid == 0) {
    __builtin_amdgcn_fence(__ATOMIC_RELEASE, "agent");
    const unsigned g = blockIdx.x & 7u, per = gridDim.x >> 3;
    const unsigned v = __hip_atomic_fetch_add(bar + g * 64, 1u, __ATOMIC_RELAXED, __HIP_MEMORY_SCOPE_AGENT) + 1u;
    if (v == epoch * per) {
      const unsigned t = __hip_atomic_fetch_add(bar + 8 * 64, 1u, __ATOMIC_RELAXED, __HIP_MEMORY_SCOPE_AGENT) + 1u;
      if (t == epoch * 8u) __hip_atomic_store(bar + 9 * 64, epoch, __ATOMIC_RELAXED, __HIP_MEMORY_SCOPE_AGENT);
    }
    while (__hip_atomic_load(bar + 9 * 64, __ATOMIC_RELAXED, __HIP_MEMORY_SCOPE_AGENT) < epoch) __builtin_amdgcn_s_sleep(1);
    __builtin_amdgcn_fence(__ATOMIC_ACQUIRE, "agent");
  }
  __syncthreads();
}

#ifndef DUP_MASK
#define DUP_MASK 0
#endif
#define SYNC fast_grid_barrier(bar, ++epoch, btid);
#define RUN(K, CALL) { CALL; if ((DUP_MASK >> (K)) & 1) { grid.sync(); CALL; } }
#define PEER(L, MM) \
  RUN(3, phase_norm2(p, L, MM)) SYNC \
  RUN(4, phase_peer_score(p, L, MM, sm)) SYNC \
  RUN(8, phase_peer_combine(p, MM)) SYNC \
  RUN(9, phase_peer_dots(p, L, MM)) SYNC \
  RUN(10, phase_peer_weights(p, MM)) SYNC \
  if ((DUP_MASK >> 12) & 1) { phase_peer_values(p, L, MM, true); grid.sync(); } \
  phase_peer_values(p, L, MM, false); SYNC \
  RUN(11, phase_next_norm(p, L, MM))
__global__ void __launch_bounds__(256, 2) mega_kernel(Params p) {
  __shared__ Smem sm;
  cg::grid_group grid = cg::this_grid();
  unsigned* bar = (unsigned*)(p.ws + OFF_BAR);
  unsigned epoch = 0;
  const int btid = (int)__builtin_amdgcn_workitem_id_x();
  RUN(0, phase_setup(p, sm))
  grid.sync();
  RUN(0, phase_modfin(p)) SYNC
  RUN(15, phase_first_norm(p)) SYNC
  RUN(1, phase_cm_in(p, 0, sm)) SYNC
  RUN(2, phase_cm_gate(p, 0, sm)) SYNC
  RUN(15, phase_cm_out(p, 0, 0, sm)) SYNC
  PEER(0, TT) SYNC
  RUN(5, phase_ssm_in(p, 0, sm)) SYNC
  RUN(6, phase_scan(p, 0, sm)) SYNC
  RUN(7, phase_ssm_comb(p, 0)) SYNC
  RUN(15, phase_ssm_out(p, 1, 0, TT, sm)) SYNC
  PEER(1, TT) SYNC
  RUN(1, phase_cm_in(p, 1, sm)) SYNC
  RUN(2, phase_cm_gate(p, 1, sm)) SYNC
  RUN(15, phase_cm_out(p, 2, 1, sm)) SYNC
  PEER(2, TT) SYNC
  RUN(5, phase_ssm_in(p, 1, sm)) SYNC
  RUN(6, phase_scan(p, 1, sm)) SYNC
  RUN(7, phase_ssm_comb(p, 1)) SYNC
  RUN(15, phase_ssm_out(p, 3, 1, TL, sm)) SYNC
  PEER(3, TL)
}

extern "C" void kernel_launch(void* const* d_in, const int* in_sizes, int n_in, void* d_out, int out_size, void* d_ws, size_t ws_size,
                              hipStream_t stream) {
  static int grid_blocks = 0;
  if (!grid_blocks) {
    int dev = 0, cus = 0, per_cu = 0;
    hipGetDevice(&dev);
    hipDeviceGetAttribute(&cus, hipDeviceAttributeMultiprocessorCount, dev);
    hipOccupancyMaxActiveBlocksPerMultiprocessor(&per_cu, mega_kernel, 256, 0);
    if (per_cu > 2) per_cu = 2;
    if (per_cu < 1) per_cu = 1;
    grid_blocks = cus * per_cu;
    grid_blocks -= grid_blocks % 8;
  }
  if (ws_size < WS_TOTAL) { fprintf(stderr, "workspace too small: %zu < %zu\n", ws_size, (size_t)WS_TOTAL); return; }
  Params p{};
  for (int i = 0; i < 29; ++i) p.in[i] = (const float*)d_in[i];
  p.out = (float*)d_out;
  p.ws = (unsigned char*)d_ws;
  hipMemsetAsync((unsigned char*)d_ws + OFF_BAR, 0, 4096, stream);
  void* args[] = {&p};
  hipError_t e = hipLaunchCooperativeKernel((void*)mega_kernel, dim3(grid_blocks), dim3(256), args, 0, stream);
  if (e != hipSuccess) fprintf(stderr, "cooperative launch failed: %s (grid %d)\n", hipGetErrorString(e), grid_blocks);
}
```
